# Optimizing an MI355X kernel written in HIP

```python
import jax, jax.numpy as jnp
from jax import lax
import numpy as np


D_MODEL = 2048
BATCH = 16
SEQ = 256
DEPTH = 2
DEC_BATCH = 8
DEC_SEQ = 1024
PAST_LEN = 512

GRID_W = 64
HGRN_HEADS = 8
HGRN_DK = 128
HGRN_DV = 128
HGRN_WIDTH = HGRN_HEADS * HGRN_DV
HGRN_CHUNK = 64
CONV_WIDTH = 512
NA_HEADS = 4
NA_HEAD_DIM = 128
NA_WIDTH = NA_HEADS * NA_HEAD_DIM
NA_KH = 8
NA_KW = 16
MIX_WIDTH = HGRN_WIDTH + CONV_WIDTH + NA_WIDTH
IN_PROJ_WIDTH = 5 * HGRN_WIDTH + 3 * CONV_WIDTH + 3 * NA_WIDTH
FFN_HIDDEN = ((8 * D_MODEL + 3 * 256 - 1) // (3 * 256)) * 256
ATTN_BLOCK = 128
EPS = 1e-6

kernel_name = 'hybrid_dit_hgrn2_shortconv_natten'


def rmsnorm(x, w):
    xf = x.astype(jnp.float32)
    y = xf * lax.rsqrt(jnp.mean(xf * xf, axis=-1, keepdims=True) + EPS)
    return (y * w.astype(jnp.float32)).astype(x.dtype)


def modulate(h, shift, scale):
    return h * (1.0 + scale) + shift


def adaln_params(cvec, w_ada_l, b_ada_l):
    mod = jax.nn.silu(cvec) @ w_ada_l + b_ada_l
    return jnp.split(mod[..., None, :], 6, axis=-1)


def split_in_proj(p):
    sizes = [HGRN_WIDTH] * 5 + [CONV_WIDTH] * 3 + [NA_WIDTH] * 3
    bounds = [int(s) for s in np.cumsum(sizes)[:-1]]
    return jnp.split(p, bounds, axis=-1)


def mixer_inputs(x, shift, scale, norm_w, w_in_l):
    h = modulate(rmsnorm(x, norm_w), shift, scale)
    return split_in_proj(h @ w_in_l)


def ffn_residual(x, shift, scale, gate, norm_w, wg, wu, wd):
    h = modulate(rmsnorm(x, norm_w), shift, scale)
    return x + gate * ((jax.nn.silu(h @ wg) * (h @ wu)) @ wd)


def hgrn_lower_bounds(lb_raw):
    p = jax.nn.softmax(lb_raw.astype(jnp.float32), axis=1)
    cp = jnp.cumsum(p, axis=1)
    return cp - cp[:, :1]


def hgrn2_gates(f_raw, lb):
    xf = f_raw.astype(jnp.float32)
    log_f = jnp.logaddexp(jnp.log(lb), jnp.log1p(-lb) + jax.nn.log_sigmoid(xf))
    k = (1.0 - lb) * jax.nn.sigmoid(-xf)
    return log_f, k


def hgrn2_chunk_scan(q, k, v, log_f, s0):
    B, N, H, K = q.shape
    nc = N // HGRN_CHUNK

    def to_chunks(t):
        return t.astype(jnp.float32).reshape(B, nc, HGRN_CHUNK, H, t.shape[-1]).transpose(1, 0, 3, 2, 4)

    causal = jnp.tril(jnp.ones((HGRN_CHUNK, HGRN_CHUNK), dtype=bool))[:, :, None]

    def step(s, inp):
        qc, kc, vc, gc = inp
        b = jnp.cumsum(gc, axis=2)
        b_last = b[:, :, -1:, :]
        o_inter = jnp.einsum('bhik,bhkv->bhiv', qc * jnp.exp(b), s)
        decay = jnp.exp(jnp.where(causal, b[:, :, :, None, :] - b[:, :, None, :, :], -jnp.inf))
        attn = jnp.einsum('bhik,bhjk,bhijk->bhij', qc, kc, decay)
        o = o_inter + jnp.einsum('bhij,bhjv->bhiv', attn, vc)
        s_new = jnp.exp(b_last[:, :, 0, :])[..., None] * s + jnp.einsum('bhjk,bhjv->bhkv', kc * jnp.exp(b_last - b), vc)
        return s_new, o

    s_fin, o = lax.scan(step, s0.astype(jnp.float32), (to_chunks(q), to_chunks(k), to_chunks(v), to_chunks(log_f)))
    o = o.transpose(1, 0, 3, 2, 4).reshape(B, N, H, v.shape[-1])
    return o, s_fin


def hgrn2_bidirectional(hq, hi, hf_f, hf_b, hg, lb_f, lb_b, gnorm_w, s_f0, s_b0):
    B, N, _ = hq.shape

    def heads(t):
        return t.reshape(B, N, HGRN_HEADS, -1)

    def flip(t):
        return jnp.flip(t, axis=1)

    q = heads(hq).astype(jnp.float32) * (HGRN_DK ** -0.5)
    v = heads(hi).astype(jnp.float32)
    lf_f, k_f = hgrn2_gates(heads(hf_f), lb_f.reshape(HGRN_HEADS, HGRN_DK))
    lf_b, k_b = hgrn2_gates(heads(hf_b), lb_b.reshape(HGRN_HEADS, HGRN_DK))
    o_f, s_f = hgrn2_chunk_scan(q, k_f, v, lf_f, s_f0)
    o_b, s_b = hgrn2_chunk_scan(flip(q), flip(k_b), flip(v), flip(lf_b), s_b0)
    o = o_f + flip(o_b)
    o = rmsnorm(o, gnorm_w) * jax.nn.silu(heads(hg).astype(jnp.float32))
    return o.reshape(B, N, HGRN_WIDTH).astype(hq.dtype), s_f, s_b


def short_conv_mixer(b_gate, c_gate, xc, conv_w_l):
    u = c_gate * xc
    up = jnp.pad(u, ((0, 0), (1, 1), (0, 0)))
    y = up[:, :-2] * conv_w_l[0] + up[:, 1:-1] * conv_w_l[1] + up[:, 2:] * conv_w_l[2]
    return b_gate * y


def context_self_attention(q, k, v):
    B, L, H, Dh = q.shape
    nb = L // ATTN_BLOCK
    scale = Dh ** -0.5
    qb = q.reshape(B, nb, ATTN_BLOCK, H, Dh).transpose(1, 0, 2, 3, 4)

    def blk(qi):
        s = jnp.einsum('bqhd,blhd->bhql', qi, k).astype(jnp.float32) * scale
        p = jax.nn.softmax(s, axis=-1).astype(v.dtype)
        return jnp.einsum('bhql,blhd->bqhd', p, v)

    o = lax.map(blk, qb)
    return o.transpose(1, 0, 2, 3, 4).reshape(B, L, H * Dh)


def latent_neighbourhood_attention(q, k, v, k_ctx, v_ctx, rpb_l):
    B, N, H, Dh = q.shape
    rows = N // GRID_W
    kh = min(NA_KH, rows)
    scale = Dh ** -0.5
    row_start = np.clip(np.arange(rows) - kh // 2, 0, rows - kh).astype(np.int32)
    col = np.arange(GRID_W)
    col_start = np.clip(col - NA_KW // 2, 0, GRID_W - NA_KW)
    col_mask = (col[None, :] >= col_start[:, None]) & (col[None, :] < col_start[:, None] + NA_KW)
    dc_idx = np.clip(col[None, :] - col[:, None] + NA_KW - 1, 0, 2 * NA_KW - 2)
    col_mask_j = jnp.asarray(col_mask)[:, None, :]
    k_grid = k.reshape(B, rows, GRID_W, H, Dh)
    v_grid = v.reshape(B, rows, GRID_W, H, Dh)
    q_rows = q.reshape(B, rows, GRID_W, H, Dh).transpose(1, 0, 2, 3, 4)
    n_loc = kh * GRID_W

    def row_fn(inp):
        q_r, rs, r = inp
        k_band = lax.dynamic_slice_in_dim(k_grid, rs, kh, axis=1)
        v_band = lax.dynamic_slice_in_dim(v_grid, rs, kh, axis=1)
        dr_idx = rs + jnp.arange(kh, dtype=jnp.int32) - r + (NA_KH - 1)
        bias = rpb_l[:, dr_idx][:, :, dc_idx].transpose(0, 2, 1, 3)
        s_loc = jnp.einsum('bqhd,bkwhd->bhqkw', q_r, k_band).astype(jnp.float32) * scale + bias.astype(jnp.float32)
        s_loc = jnp.where(col_mask_j, s_loc, -jnp.inf)
        s_ctx = jnp.einsum('bqhd,blhd->bhql', q_r, k_ctx).astype(jnp.float32) * scale
        s = jnp.concatenate([s_loc.reshape(B, H, GRID_W, n_loc), s_ctx], axis=-1)
        p = jax.nn.softmax(s, axis=-1).astype(v.dtype)
        p_loc = p[..., :n_loc].reshape(B, H, GRID_W, kh, GRID_W)
        p_ctx = p[..., n_loc:]
        return jnp.einsum('bhqkw,bkwhd->bqhd', p_loc, v_band) + jnp.einsum('bhql,blhd->bqhd', p_ctx, v_ctx)

    o = lax.map(row_fn, (q_rows, jnp.asarray(row_start), jnp.arange(rows, dtype=jnp.int32)))
    return o.transpose(1, 0, 2, 3, 4).reshape(B, N, H * Dh)


def context_layer(x, mods, norm_mix_w_l, w_in_l, lb_f, lb_b, gnorm_w_l, conv_w_l, rpb_unused_free, w_out_l,
                  norm_ffn_w_l, wg, wu, wd):
    sh1, sc1, g1, sh2, sc2, g2 = mods
    hq, hi, hff, hfb, hg, cb, cc, cx, nq, nk, nv = mixer_inputs(x, sh1, sc1, norm_mix_w_l, w_in_l)
    B, L, _ = x.shape
    s0 = jnp.zeros((B, HGRN_HEADS, HGRN_DK, HGRN_DV), jnp.float32)
    o_a, s_f, s_b = hgrn2_bidirectional(hq, hi, hff, hfb, hg, lb_f, lb_b, gnorm_w_l, s0, s0)
    o_b = short_conv_mixer(cb, cc, cx, conv_w_l)
    k_c = nk.reshape(B, L, NA_HEADS, NA_HEAD_DIM)
    v_c = nv.reshape(B, L, NA_HEADS, NA_HEAD_DIM)
    o_c = context_self_attention(nq.reshape(B, L, NA_HEADS, NA_HEAD_DIM), k_c, v_c)
    x = x + g1 * (jnp.concatenate([o_a, o_b, o_c], axis=-1) @ w_out_l)
    x = ffn_residual(x, sh2, sc2, g2, norm_ffn_w_l, wg, wu, wd)
    return x, k_c, v_c, jnp.stack([s_f, s_b], axis=1)


def latent_layer(x, mods, k_ctx, v_ctx, s_f0, s_b0, norm_mix_w_l, w_in_l, lb_f, lb_b, gnorm_w_l, conv_w_l, rpb_l,
                 w_out_l, norm_ffn_w_l, wg, wu, wd):
    sh1, sc1, g1, sh2, sc2, g2 = mods
    hq, hi, hff, hfb, hg, cb, cc, cx, nq, nk, nv = mixer_inputs(x, sh1, sc1, norm_mix_w_l, w_in_l)
    B, N, _ = x.shape
    o_a, _, _ = hgrn2_bidirectional(hq, hi, hff, hfb, hg, lb_f, lb_b, gnorm_w_l, s_f0, s_b0)
    o_b = short_conv_mixer(cb, cc, cx, conv_w_l)

    def heads(t):
        return t.reshape(B, N, NA_HEADS, NA_HEAD_DIM)

    o_c = latent_neighbourhood_attention(heads(nq), heads(nk), heads(nv), k_ctx, v_ctx, rpb_l)
    x = x + g1 * (jnp.concatenate([o_a, o_b, o_c], axis=-1) @ w_out_l)
    return ffn_residual(x, sh2, sc2, g2, norm_ffn_w_l, wg, wu, wd)


def setup_inputs(seed: int = 0) -> dict:
    key = jax.random.key(seed)
    ks = jax.random.split(key, 24)

    def nrm(k, shape, s):
        return jax.random.normal(k, shape, jnp.float32) * s

    return {
        'x_prompt': nrm(ks[0], (BATCH, SEQ, D_MODEL), 1.0),
        'x_sample': nrm(ks[1], (DEC_BATCH, DEC_SEQ, D_MODEL), 1.0),
        'cache_na_k': nrm(ks[2], (DEC_BATCH, DEPTH, PAST_LEN, NA_HEADS, NA_HEAD_DIM), 1.0),
        'cache_na_v': nrm(ks[3], (DEC_BATCH, DEPTH, PAST_LEN, NA_HEADS, NA_HEAD_DIM), 1.0),
        'state_hgrn': nrm(ks[4], (DEC_BATCH, DEPTH, 2, HGRN_HEADS, HGRN_DK, HGRN_DV), 0.5),
        'c': nrm(ks[5], (DEC_BATCH, D_MODEL), 1.0),
        'c_ctx': nrm(ks[6], (D_MODEL,), 1.0),
        'w_ada': nrm(ks[7], (DEPTH, D_MODEL, 6 * D_MODEL), 0.5 * D_MODEL ** -0.5),
        'b_ada': nrm(ks[8], (DEPTH, 6 * D_MODEL), 0.02),
        'norm_mix_w': 1.0 + nrm(ks[9], (DEPTH, D_MODEL), 0.05),
        'w_in': nrm(ks[10], (DEPTH, D_MODEL, IN_PROJ_WIDTH), D_MODEL ** -0.5),
        'hgrn_lb_raw': nrm(ks[11], (2, DEPTH, HGRN_WIDTH), 1.0),
        'hgrn_gnorm_w': 1.0 + nrm(ks[12], (DEPTH, HGRN_DV), 0.05),
        'conv_w': nrm(ks[13], (DEPTH, 3, CONV_WIDTH), 0.5),
        'na_rpb': nrm(ks[14], (DEPTH, NA_HEADS, 2 * NA_KH - 1, 2 * NA_KW - 1), 0.5),
        'w_out': nrm(ks[15], (DEPTH, MIX_WIDTH, D_MODEL), MIX_WIDTH ** -0.5),
        'norm_ffn_w': 1.0 + nrm(ks[16], (DEPTH, D_MODEL), 0.05),
        'w_ffn_gate': nrm(ks[17], (DEPTH, D_MODEL, FFN_HIDDEN), D_MODEL ** -0.5),
        'w_ffn_up': nrm(ks[18], (DEPTH, D_MODEL, FFN_HIDDEN), D_MODEL ** -0.5),
        'w_ffn_down': nrm(ks[19], (DEPTH, FFN_HIDDEN, D_MODEL), FFN_HIDDEN ** -0.5),
        'final_norm_w': 1.0 + nrm(ks[20], (D_MODEL,), 0.05),
    }


def reference(x_prompt, x_sample, cache_na_k, cache_na_v, state_hgrn, c, c_ctx, w_ada, b_ada, norm_mix_w, w_in,
              hgrn_lb_raw, hgrn_gnorm_w, conv_w, na_rpb, w_out, norm_ffn_w, w_ffn_gate, w_ffn_up, w_ffn_down,
              final_norm_w):
    lbs = hgrn_lower_bounds(hgrn_lb_raw)
    xp, xs = x_prompt, x_sample
    new_k, new_v, new_s = [], [], []
    for l in range(DEPTH):
        xp, k_c, v_c, s_c = context_layer(
            xp, adaln_params(c_ctx, w_ada[l], b_ada[l]), norm_mix_w[l], w_in[l], lbs[0, l], lbs[1, l],
            hgrn_gnorm_w[l], conv_w[l], None, w_out[l], norm_ffn_w[l], w_ffn_gate[l], w_ffn_up[l], w_ffn_down[l])
        new_k.append(k_c)
        new_v.append(v_c)
        new_s.append(s_c)
        xs = latent_layer(
            xs, adaln_params(c, w_ada[l], b_ada[l]), cache_na_k[:, l], cache_na_v[:, l], state_hgrn[:, l, 0],
            state_hgrn[:, l, 1], norm_mix_w[l], w_in[l], lbs[0, l], lbs[1, l], hgrn_gnorm_w[l], conv_w[l], na_rpb[l],
            w_out[l], norm_ffn_w[l], w_ffn_gate[l], w_ffn_up[l], w_ffn_down[l])
    y_prompt = rmsnorm(xp, final_norm_w)
    y_sample = rmsnorm(xs, final_norm_w)
    new_na_k = jnp.stack(new_k, axis=1)
    new_na_v = jnp.stack(new_v, axis=1)
    new_hgrn_state = jnp.stack(new_s, axis=1).astype(x_prompt.dtype)
    return (y_prompt, y_sample, new_na_k, new_na_v, new_hgrn_state)
```

```cpp
#include <hip/hip_runtime.h>
#include <hip/hip_cooperative_groups.h>
#include <cstdio>
#include <cstdint>
namespace cg = cooperative_groups;

#define DI __device__ __forceinline__
#define LAS __attribute__((address_space(3)))
typedef unsigned short bf16_t;
typedef short bf16x8 __attribute__((ext_vector_type(8)));
typedef short s16x4 __attribute__((ext_vector_type(4)));
typedef float f32x2 __attribute__((ext_vector_type(2)));
typedef float f32x4 __attribute__((ext_vector_type(4)));
typedef float f32x16 __attribute__((ext_vector_type(16)));
typedef unsigned u32x2 __attribute__((ext_vector_type(2)));
typedef unsigned u32x4 __attribute__((ext_vector_type(4)));
typedef __bf16 bfv2 __attribute__((ext_vector_type(2)));

constexpr int T = 12288, TP = 4096, D = 2048, NIN = 8192, FF = 5632, NGU = 11264;
constexpr float EPS = 1e-6f;
constexpr float QSCALE = 0.08838834764831845f;
constexpr int C_HQ = 0, C_HI = 1024, C_HFF = 2048, C_HFB = 3072, C_HG = 4096, C_CB = 5120, C_CC = 5632, C_CX = 6144, C_NQ = 6656, C_NK = 7168, C_NV = 7680;
constexpr size_t O_Y = 0, O_NK = (size_t)T * D, O_NV = O_NK + 4194304, O_ST = O_NV + 4194304;
constexpr size_t WS_X = 0;
constexpr size_t WS_H = WS_X + (size_t)T * D * 4;
constexpr size_t WS_MIX = WS_H + (size_t)T * D * 2;
constexpr size_t WS_P = WS_MIX + (size_t)T * D * 2;
constexpr size_t WS_OF = WS_P + (size_t)T * NIN * 2;
constexpr size_t WS_OB = WS_OF + (size_t)T * 1024 * 4;
constexpr size_t WS_VT = WS_OB + (size_t)T * 1024 * 4;
constexpr size_t WS_HIT = WS_VT + (size_t)512 * T * 2;
constexpr size_t WS_KC = WS_HIT + (size_t)1024 * T * 2;
constexpr size_t WS_VCT = WS_KC + (size_t)8 * 2 * 4 * 512 * 128 * 2;
constexpr size_t WS_WIN = WS_VCT + (size_t)8 * 2 * 4 * 512 * 128 * 2;
constexpr size_t WS_WOUT = WS_WIN + (size_t)2 * NIN * D * 2;
constexpr size_t WS_WGU = WS_WOUT + (size_t)2 * D * D * 2;
constexpr size_t WS_WD = WS_WGU + (size_t)2 * NGU * D * 2;
constexpr size_t WS_MOD = WS_WD + (size_t)2 * D * FF * 2;
constexpr size_t WS_FLG = WS_MOD + (size_t)2 * 9 * 12288 * 4;
constexpr size_t WS_BAR = WS_FLG + 4096;
constexpr size_t WS_END = WS_BAR + 16384;
constexpr int LDS_BYTES = 131072 + 64;

struct Prm { const float* in[21]; float* out; unsigned char* ws; int ph_lo, ph_hi; };

DI unsigned pk2(float lo, float hi) { f32x2 v = {lo, hi}; return __builtin_bit_cast(unsigned, __builtin_convertvector(v, bfv2)); }
DI bf16_t f2bf(float f) { return __builtin_bit_cast(unsigned short, (__bf16)f); }
DI float bf2f(bf16_t b) { return __uint_as_float(((unsigned)b) << 16); }
DI float bflo(unsigned w) { return __uint_as_float(w << 16); }
DI float bfhi(unsigned w) { return __uint_as_float(w & 0xffff0000u); }
DI float shx(float v, int o, int lane) { return __int_as_float(__builtin_amdgcn_ds_bpermute((lane ^ o) << 2, __float_as_int(v))); }
DI float wave_sum(float v, int lane) {
#pragma unroll
    for (int o = 1; o < 64; o <<= 1) v += shx(v, o, lane);
    return v;
}
DI void lds_wait() { asm volatile("s_waitcnt lgkmcnt(0)" ::: "memory"); }
DI float sigmoidf_(float x) { return __builtin_amdgcn_rcpf(1.f + __expf(-x)); }
DI float siluf_(float x) { return x * __builtin_amdgcn_rcpf(1.f + __expf(-x)); }
#define MFMA32(a, b, c) __builtin_amdgcn_mfma_f32_32x32x16_bf16((a), (b), (c), 0, 0, 0)
#define MFMA16(a, b, c) __builtin_amdgcn_mfma_f32_16x16x32_bf16((a), (b), (c), 0, 0, 0)
DI int crow(int reg, int h) { return (reg & 3) + 8 * (reg >> 2) + 4 * h; }
DI bf16x8 pack8(const f32x16& x, int s) {
    u32x4 p; p.x = pk2(x[8 * s], x[8 * s + 1]); p.y = pk2(x[8 * s + 2], x[8 * s + 3]); p.z = pk2(x[8 * s + 4], x[8 * s + 5]); p.w = pk2(x[8 * s + 6], x[8 * s + 7]);
    return __builtin_bit_cast(bf16x8, p);
}
DI bf16x8 cat4(s16x4 lo, s16x4 hi) { return __builtin_shufflevector(lo, hi, 0, 1, 2, 3, 4, 5, 6, 7); }

DI int opaque_tid() { int t = threadIdx.x; asm volatile("" : "+v"(t)); return t; }

#define XB_TMO      128
#define XB_XCNT(j)  (256  + 64 * (j))
#define XB_XSUB(j)  (1280 + 64 * (j))
#define XB_XGEN(j)  (2304 + 64 * (j))
#define XB_TOP      3328
#define XB_TOPGEN   3392
#define XCD_BAR_WORDS 3456
#define XB_SPIN_CAP (1u << 18)

__device__ __forceinline__ unsigned xb_ld(unsigned* p)              { return __hip_atomic_load(p, __ATOMIC_RELAXED, __HIP_MEMORY_SCOPE_AGENT); }
__device__ __forceinline__ unsigned xb_add(unsigned* p, unsigned v) { return __hip_atomic_fetch_add(p, v, __ATOMIC_RELAXED, __HIP_MEMORY_SCOPE_AGENT); }
__device__ __forceinline__ unsigned xb_xcc_id() { return (unsigned)__builtin_amdgcn_s_getreg((3 << 11) | 20) & 0xFu; }
#define XB_SPIN(cond, bar) do { unsigned _sp = 0; while (cond) { __builtin_amdgcn_s_sleep(1); \
    if ((++_sp & 255u) == 0u) { if (xb_ld(&(bar)[XB_TMO])) break; if (_sp > XB_SPIN_CAP) { atomicAdd(&(bar)[XB_TMO], 1u); break; } } } } while (0)

struct XcdBarrier {
    unsigned* bar; unsigned x;
    volatile LAS unsigned* st;
};

__device__ __forceinline__ XcdBarrier xcd_barrier_post(unsigned* bar, volatile LAS unsigned* st) {
    XcdBarrier b; b.bar = bar; b.x = xb_xcc_id(); b.st = st;
    if (threadIdx.x == 0) (void)xb_add(&bar[XB_XCNT(b.x)], 1u);
    return b;
}
__device__ __forceinline__ void xcd_barrier_complete(unsigned* bar, unsigned x, unsigned& nloc, unsigned& nx) {
    const unsigned G = gridDim.x * gridDim.y * gridDim.z;
    unsigned sum, cnt, mine, sp = 0u;
    for (;;) {
        sum = 0u; cnt = 0u; mine = 0u;
        unsigned cv[16];
#pragma unroll
        for (unsigned j = 0; j < 16; ++j) cv[j] = xb_ld(&bar[XB_XCNT(j)]);
#pragma unroll
        for (unsigned j = 0; j < 16; ++j) { const unsigned c = cv[j]; sum += c; cnt += (c > 0u) ? 1u : 0u; mine = (j == x) ? c : mine; }
        if (sum == G) break;
        __builtin_amdgcn_s_sleep(1);
        if ((++sp & 255u) == 0u) { if (xb_ld(&bar[XB_TMO])) break; if (sp > XB_SPIN_CAP) { atomicAdd(&bar[XB_TMO], 1u); break; } }
    }
    nloc = mine > 0u ? mine : 1u; nx = cnt > 0u ? cnt : 1u;
}

__device__ __forceinline__ void xcd_barrier(const XcdBarrier& b) {
    asm volatile("s_waitcnt vmcnt(0)" ::: "memory");
    __syncthreads();
    if (threadIdx.x == 0) {
        unsigned* bar = b.bar;
        __builtin_amdgcn_s_waitcnt(0);
        unsigned nloc = b.st[0], nx = b.st[1];
        if (nloc == 0u) { xcd_barrier_complete(bar, b.x, nloc, nx); b.st[0] = nloc; b.st[1] = nx; }
        const unsigned old = xb_add(&bar[XB_XSUB(b.x)], 1u);
        const unsigned gen = old / nloc;
        if (old + 1u == (gen + 1u) * nloc) {
            __builtin_amdgcn_fence(__ATOMIC_RELEASE, "agent");
            asm volatile("s_waitcnt vmcnt(0)" ::: "memory");
            const unsigned og = xb_add(&bar[XB_TOP], 1u);
            const unsigned tg = og / nx;
            if (og + 1u == (tg + 1u) * nx) xb_add(&bar[XB_TOPGEN], 1u);
            else XB_SPIN(xb_ld(&bar[XB_TOPGEN]) == tg, bar);
            __builtin_amdgcn_fence(__ATOMIC_ACQUIRE, "agent");
            xb_add(&bar[XB_XGEN(b.x)], 1u);
            asm volatile("s_waitcnt vmcnt(0)" ::: "memory");
        } else {
            XB_SPIN(xb_ld(&bar[XB_XGEN(b.x)]) == gen, bar);
            __builtin_amdgcn_fence(__ATOMIC_ACQUIRE, "agent");
            asm volatile("s_waitcnt vmcnt(0)" ::: "memory");
        }
    }
    __syncthreads();
}

namespace pg8 {
#define PG8_LAS __attribute__((address_space(3)))
constexpr int BM = 256, BK = 64, HALF = 128, HTB = HALF * BK * 2  , STAGE_BYTES = 8 * HTB, NXCD = 8, WGM = 4;

__host__ __device__ __forceinline__ int lds_byte(int r, int c) { const int st = (r >> 4) * 2 + (c >> 5), rr = r & 15, cc = c & 31, ob = rr * 64 + cc * 2; return st * 1024 + (ob ^ (((ob >> 9) & 1) << 5)); }
__host__ __device__ __forceinline__ void stage_rc(int b, int& R, int& C) { const int st = b / 1024, sb = b % 1024, swz = sb ^ (((sb >> 9) & 1) << 5); R = (st >> 1) * 16 + swz / 64; C = (st & 1) * 32 + (swz % 64) / 2; }
__host__ __device__ __forceinline__ int perm32(int rho) { const int n = rho >> 4, i = rho & 15; return 8 * (i >> 2) + 4 * n + (i & 3); }

struct Unit { int pm, pn, sp, kh; };
struct Gemm { const bf16_t* A; const bf16_t* Bt; int M, N, K; };

struct StaticOrder {
    int nM, nN, nwg, G, c;
    __host__ __device__ void init(int M, int N, int G_, int c_) { nM = M / BM; nN = N / BM; nwg = nM * nN; G = G_; c = c_; }
    __host__ __device__ void map(long L, Unit& u) const {
        int wgid = (int)L; { const int q = nwg / NXCD, r = nwg % NXCD, xcd = wgid % NXCD, off = wgid / NXCD; wgid = (xcd < r ? xcd * (q + 1) : r * (q + 1) + (xcd - r) * q) + off; }
        const int nig = WGM * nN, gid = wgid / nig, fm = gid * WGM, gsz = (nM - fm) < WGM ? (nM - fm) : WGM;
        u.pm = fm + ((wgid % nig) % gsz); u.pn = (wgid % nig) / gsz;
    }
    __host__ __device__ bool next(int i, Unit& u) const {
        const long L = (long)i * G + c; if (L >= nwg) return false;
        u.sp = 0; u.kh = 0; map(L, u); return true;
    }
    __device__ __forceinline__ void a_ready(const Unit&) const {}
    __device__ __forceinline__ void done(const Unit&) const {}
};

template <int KIND> struct HalfOrder : StaticOrder {
    __host__ __device__ bool next(int i, Unit& u) const {
        const int frnd = nwg / G, rem = nwg - frnd * G;
        u.sp = 0; u.kh = 0;
        if (i < frnd) { map((long)i * G + c, u); return true; }
        if (i > frnd || rem == 0) return false;
        if (2 * rem <= G) { if (c >= 2 * rem) return false; u.sp = KIND; u.kh = c >= rem; map((long)frnd * G + (c >= rem ? c - rem : c), u); return true; }
        if (c >= rem) return false;
        map((long)frnd * G + c, u); return true;
    }
};

template <class Epi, class Sched>
__device__ __forceinline__ void gemm_phase(PG8_LAS unsigned char* lds, const Gemm g, const Sched& S, const Epi& E) {
    int tid_ = threadIdx.x; asm volatile("" : "+v"(tid_)); const int tid = tid_, wid = __builtin_amdgcn_readfirstlane(tid >> 6), lane = tid & 63, wr = wid >> 2, wc = wid & 3, fr = lane & 15, fq = lane >> 4;
    const int K = g.K, nt = K / BK;
    unsigned voffA[2], voffB[2];
#pragma unroll
    for (int i = 0; i < 2; ++i) { int R, C; stage_rc(tid * 16 + i * 8192, R, C); const int Rb = Epi::PERM ? ((R & ~31) + perm32(R & 31)) : R;
        voffA[i] = (unsigned)(R * K + C) * 2u; voffB[i] = (unsigned)(Rb * K + C) * 2u; }
    const size_t kstep = (size_t)(BK * 2);
    const size_t hstep = (size_t)HALF * K * 2;
    const size_t tstep = 2 * hstep;
    const unsigned ldsw = (unsigned)wid * 1024u;
    const int aoff = lds_byte(wr * 64 + fr, fq * 8), boff = lds_byte(wc * 32 + fr, fq * 8);
#define PG8_SA(b, h) (((b) * 2 + (h)) * HTB)
#define PG8_SB(b, h) ((4 + (b) * 2 + (h)) * HTB)
#define PG8_STAGE(bufoff, gbase, voff) do { _Pragma("unroll") for (int _i = 0; _i < 2; ++_i) \
        __builtin_amdgcn_global_load_lds((const unsigned*)((const char*)(gbase) + (voff)[_i]), (PG8_LAS unsigned*)(lds + (bufoff) + ldsw + _i * 8192), 16, 0, 0); } while (0)
#define PG8_LDA(dst, b, h) do { _Pragma("unroll") for (int m = 0; m < 4; ++m) _Pragma("unroll") for (int k = 0; k < 2; ++k) dst[m][k] = *(const PG8_LAS bf16x8*)(lds + PG8_SA(b, h) + aoff + m * 2048 + k * 1024); } while (0)
#define PG8_LDB(dst, b, h) do { _Pragma("unroll") for (int n = 0; n < 2; ++n) _Pragma("unroll") for (int k = 0; k < 2; ++k) dst[n][k] = *(const PG8_LAS bf16x8*)(lds + PG8_SB(b, h) + boff + n * 2048 + k * 1024); } while (0)
#define PG8_MMA(ai, bj, At, Bt) do { __builtin_amdgcn_s_setprio(1); _Pragma("unroll") for (int m = 0; m < 4; ++m) _Pragma("unroll") for (int n = 0; n < 2; ++n) _Pragma("unroll") for (int k = 0; k < 2; ++k) \
        acc[ai][bj][m][n] = __builtin_amdgcn_mfma_f32_16x16x32_bf16(Bt[n][k], At[m][k], acc[ai][bj][m][n], 0, 0, 0); __builtin_amdgcn_s_setprio(0); } while (0)
#define PG8_WAIT_V(n) asm volatile("s_waitcnt vmcnt(" #n ")" ::: "memory")
#define PG8_WAIT_L(n) asm volatile("s_waitcnt lgkmcnt(" #n ")" ::: "memory")
#define PG8_BAR __builtin_amdgcn_s_barrier()
#define PG8_SCHED __builtin_amdgcn_sched_barrier(0)
    Unit cur, nxt; int ui = 0;
    if (!S.next(0, cur)) return;
    f32x4 acc[2][2][4][2];
#pragma unroll
    for (int a = 0; a < 2; ++a)
#pragma unroll
        for (int b = 0; b < 2; ++b)
#pragma unroll
            for (int m = 0; m < 4; ++m)
#pragma unroll
                for (int n = 0; n < 2; ++n) acc[a][b][m][n] = (f32x4){0.f, 0.f, 0.f, 0.f};
    bf16x8 At[4][2], B0[2][2], B1[2][2];
    const char* cA = (const char*)g.A + (size_t)cur.pm * tstep + (cur.sp == 2 ? (size_t)cur.kh * hstep : 0); const char* cB = (const char*)g.Bt + (size_t)cur.pn * tstep + (cur.sp == 1 ? (size_t)cur.kh * hstep : 0);
    bool full = cur.sp != 1, fullm = cur.sp != 2;
    S.a_ready(cur);
    PG8_STAGE(PG8_SB(0, 0), cB, voffB); PG8_STAGE(PG8_SA(0, 0), cA, voffA); PG8_STAGE(PG8_SB(0, 1), cB + hstep, voffB); PG8_STAGE(PG8_SA(0, 1), cA + hstep, voffA);
    if (wr == 1) PG8_BAR;
    PG8_WAIT_V(4); PG8_BAR;
    PG8_STAGE(PG8_SB(1, 0), cB + kstep, voffB); PG8_STAGE(PG8_SA(1, 0), cA + kstep, voffA); PG8_STAGE(PG8_SB(1, 1), cB + hstep + kstep, voffB);
    PG8_WAIT_V(6); PG8_BAR;
    for (;;) {
        const bool has_next = S.next(ui + 1, nxt);
        const char* nA = has_next ? (const char*)g.A + (size_t)nxt.pm * tstep + (nxt.sp == 2 ? (size_t)nxt.kh * hstep : 0) : cA; const char* nB = has_next ? (const char*)g.Bt + (size_t)nxt.pn * tstep + (nxt.sp == 1 ? (size_t)nxt.kh * hstep : 0) : cB;
        for (int t = 0; t < nt; t += 2) {
            const bool last = (t == nt - 2);
            const char* a1 = cA + (size_t)(t + 1) * kstep;
            const char* a2 = last ? nA : cA + (size_t)(t + 2) * kstep; const char* b2 = last ? nB : cB + (size_t)(t + 2) * kstep;
            const char* a3 = a2 + kstep; const char* b3 = b2 + kstep;
            if (last && has_next) S.a_ready(nxt);
            PG8_LDB(B0, 0, 0); PG8_SCHED; PG8_LDA(At, 0, 0); PG8_STAGE(PG8_SA(1, 1), a1 + hstep, voffA);
            PG8_WAIT_L(8); PG8_BAR; PG8_WAIT_L(0); PG8_MMA(0, 0, At, B0); PG8_BAR; PG8_SCHED;
            if (full) PG8_LDB(B1, 0, 1); PG8_STAGE(PG8_SB(0, 0), b2, voffB);
            PG8_BAR; PG8_WAIT_L(0); if (full) PG8_MMA(0, 1, At, B1); PG8_BAR;
            if (fullm) PG8_LDA(At, 0, 1); PG8_STAGE(PG8_SA(0, 0), a2, voffA);
            PG8_BAR; PG8_WAIT_L(0); if (fullm) PG8_MMA(1, 0, At, B0); PG8_BAR; PG8_SCHED;
            PG8_STAGE(PG8_SB(0, 1), b2 + hstep, voffB);
            PG8_WAIT_V(6); PG8_BAR; if (full && fullm) PG8_MMA(1, 1, At, B1); PG8_BAR;
            PG8_LDB(B0, 1, 0); PG8_SCHED; PG8_LDA(At, 1, 0); PG8_STAGE(PG8_SA(0, 1), a2 + hstep, voffA);
            PG8_WAIT_L(8); PG8_BAR; PG8_WAIT_L(0); PG8_MMA(0, 0, At, B0); PG8_BAR; PG8_SCHED;
            if (full) PG8_LDB(B1, 1, 1); PG8_STAGE(PG8_SB(1, 0), b3, voffB);
            PG8_BAR; PG8_WAIT_L(0); if (full) PG8_MMA(0, 1, At, B1); PG8_BAR;
            if (fullm) PG8_LDA(At, 1, 1); PG8_STAGE(PG8_SA(1, 0), a3, voffA);
            PG8_BAR; PG8_WAIT_L(0); if (fullm) PG8_MMA(1, 0, At, B0); PG8_BAR; PG8_SCHED;
            PG8_STAGE(PG8_SB(1, 1), b3 + hstep, voffB);
            PG8_WAIT_V(6); PG8_BAR; if (full && fullm) PG8_MMA(1, 1, At, B1); PG8_BAR;
        }
        if constexpr (!Epi::AFTER_DRAIN) { E(acc, cur, wr, wc, fr, fq); S.done(cur); }
        if (!has_next) break;
#pragma unroll
        for (int a = 0; a < 2; ++a)
#pragma unroll
            for (int b = 0; b < 2; ++b)
#pragma unroll
                for (int m = 0; m < 4; ++m)
#pragma unroll
                    for (int n = 0; n < 2; ++n) acc[a][b][m][n] = (f32x4){0.f, 0.f, 0.f, 0.f};
        cur = nxt; cA = nA; cB = nB; ++ui; full = cur.sp != 1; fullm = cur.sp != 2;
    }
    PG8_WAIT_V(0);
    if (wr == 0) PG8_BAR;
    PG8_BAR;
    if constexpr (Epi::AFTER_DRAIN) { E.fused(acc, cur, wr, wc, fr, fq, lds, wid, lane); S.done(cur); }
#undef PG8_SA
#undef PG8_SB
#undef PG8_STAGE
#undef PG8_LDA
#undef PG8_LDB
#undef PG8_MMA
#undef PG8_WAIT_V
#undef PG8_WAIT_L
#undef PG8_BAR
#undef PG8_SCHED
}
}


struct EpiInProj {
    static constexpr bool PERM = true, AFTER_DRAIN = false;
    bf16_t* P; bf16_t* VT; bf16_t* HIT; float* out_k; float* out_v; int layer;
    DI void operator()(const f32x4 (&acc)[2][2][4][2], const pg8::Unit& u, int wr, int wc, int fr, int fq) const {
        const int row0 = u.pm * 256 + wr * 64 + fr, col0 = u.pn * 256 + wc * 32 + 8 * fq;
        const bool skip_p = (u.pn >= 4 && u.pn < 8) || (u.pn >= 30);
#pragma unroll
        for (int ai = 0; ai < 2; ++ai)
#pragma unroll
            for (int m = 0; m < 4; ++m) {
                bf16_t* rowp = P + (size_t)(row0 + ai * 128 + m * 16) * NIN + col0;
                if (!skip_p)
#pragma unroll
                for (int bj = 0; bj < 2; ++bj) {
                    const f32x4 a0 = acc[ai][bj][m][0], a1 = acc[ai][bj][m][1];
                    u32x4 w; w.x = pk2(a0[0], a0[1]); w.y = pk2(a0[2], a0[3]); w.z = pk2(a1[0], a1[1]); w.w = pk2(a1[2], a1[3]);
                    *(u32x4*)(rowp + bj * 128) = w;
                }
            }
        const bool is_hi = (u.pn >= 4 && u.pn < 8), is_nv = (u.pn >= 30);
        if (is_hi || is_nv) {
            bf16_t* TB = is_hi ? HIT : VT;
            const int cb = u.pn * 256 - (is_hi ? C_HI : C_NV) + wc * 32 + 8 * fq;
#pragma unroll
            for (int ai = 0; ai < 2; ++ai)
#pragma unroll
                for (int m = 0; m < 4; ++m) {
                    const int row = row0 + ai * 128 + m * 16;
#pragma unroll
                    for (int bj = 0; bj < 2; ++bj)
#pragma unroll
                        for (int n = 0; n < 2; ++n)
#pragma unroll
                            for (int j = 0; j < 4; ++j) TB[(size_t)(cb + bj * 128 + 4 * n + j) * T + row] = f2bf(acc[ai][bj][m][n][j]);
                }
        }
        if (u.pm < 16 && u.pn >= 28) {
            float* dst = (u.pn < 30) ? out_k : out_v;
            const int cb = u.pn * 256 - (u.pn < 30 ? C_NK : C_NV) + wc * 32 + 8 * fq;
#pragma unroll
            for (int ai = 0; ai < 2; ++ai)
#pragma unroll
                for (int m = 0; m < 4; ++m) {
                    const int row = row0 + ai * 128 + m * 16, b = row >> 8, s = row & 255;
                    float* rp = dst + ((size_t)((b * 2 + layer) * 256 + s)) * 512 + cb;
#pragma unroll
                    for (int bj = 0; bj < 2; ++bj) { *(f32x4*)(rp + bj * 128) = acc[ai][bj][m][0]; *(f32x4*)(rp + bj * 128 + 4) = acc[ai][bj][m][1]; }
                }
        }
    }
};
struct EpiResid {
    static constexpr bool PERM = false, AFTER_DRAIN = false;
    float* X; const float* gate; const float* xp; const float* xs;
    DI void operator()(const f32x4 (&acc)[2][2][4][2], const pg8::Unit& u, int wr, int wc, int fr, int fq) const {
        const int cond = u.pm < 16 ? 0 : 1 + ((u.pm - 16) >> 2);
        const int row0 = u.pm * 256 + wr * 64 + fr;
        const float* src = xp ? (u.pm < 16 ? xp : xs - (size_t)TP * D) : X;
        if (u.sp) {
            const int col0 = u.pn * 256 + u.kh * 128 + wc * 32 + 4 * fq;
            const float* gp = gate + (size_t)cond * 12288 + col0;
            const f32x4 g0 = *(const f32x4*)gp, g1 = *(const f32x4*)(gp + 16);
#pragma unroll
            for (int ai = 0; ai < 2; ++ai) {
                f32x4 xb[4][2];
#pragma unroll
                for (int m = 0; m < 4; ++m) {
                    const float* sp_ = src + (size_t)(row0 + ai * 128 + m * 16) * D + col0;
                    xb[m][0] = *(const f32x4*)sp_; xb[m][1] = *(const f32x4*)(sp_ + 16);
                }
#pragma unroll
                for (int m = 0; m < 4; ++m) {
                    float* dp = X + (size_t)(row0 + ai * 128 + m * 16) * D + col0;
                    *(f32x4*)dp = xb[m][0] + g0 * acc[ai][0][m][0]; *(f32x4*)(dp + 16) = xb[m][1] + g1 * acc[ai][0][m][1];
                }
            }
            return;
        }
        const int col0 = u.pn * 256 + wc * 32 + 4 * fq;
        const float* gp = gate + (size_t)cond * 12288 + col0;
        f32x4 gv[4];
#pragma unroll
        for (int q = 0; q < 4; ++q) gv[q] = *(const f32x4*)(gp + (q >> 1) * 128 + (q & 1) * 16);
#pragma unroll
        for (int hb = 0; hb < 3; ++hb) {
            const int r0 = 3 * hb, nr = hb < 2 ? 3 : 2;
            f32x4 xb[3][4];
#pragma unroll
            for (int rr = 0; rr < 3; ++rr)
                if (rr < nr) {
                    const int r = r0 + rr;
#pragma unroll
                    for (int q = 0; q < 4; ++q) xb[rr][q] = *(const f32x4*)(src + (size_t)(row0 + (r >> 2) * 128 + (r & 3) * 16) * D + col0 + (q >> 1) * 128 + (q & 1) * 16);
                }
#pragma unroll
            for (int rr = 0; rr < 3; ++rr)
                if (rr < nr) {
                    const int r = r0 + rr;
#pragma unroll
                    for (int q = 0; q < 4; ++q)
                        *(f32x4*)(X + (size_t)(row0 + (r >> 2) * 128 + (r & 3) * 16) * D + col0 + (q >> 1) * 128 + (q & 1) * 16) = xb[rr][q] + gv[q] * acc[r >> 2][q >> 1][r & 3][q & 1];
                }
        }
    }
};
struct EpiSwiGLU {
    static constexpr bool PERM = true, AFTER_DRAIN = false;
    bf16_t* U;
    DI void operator()(const f32x4 (&acc)[2][2][4][2], const pg8::Unit& u, int wr, int wc, int fr, int fq) const {
        const int row0 = u.pm * 256 + (u.sp == 2 ? u.kh * 128 : 0) + wr * 64 + fr, col0 = u.pn * 128 + wc * 32 + 8 * fq;
#pragma unroll
        for (int ai = 0; ai < 2; ++ai)
            if (ai == 0 || u.sp != 2)
#pragma unroll
            for (int m = 0; m < 4; ++m) {
                bf16_t* rowp = U + (size_t)(row0 + ai * 128 + m * 16) * FF + col0;
                f32x4 v0, v1;
#pragma unroll
                for (int j = 0; j < 4; ++j) { v0[j] = siluf_(acc[ai][0][m][0][j]) * acc[ai][1][m][0][j]; v1[j] = siluf_(acc[ai][0][m][1][j]) * acc[ai][1][m][1][j]; }
                u32x4 w; w.x = pk2(v0[0], v0[1]); w.y = pk2(v0[2], v0[3]); w.z = pk2(v1[0], v1[1]); w.w = pk2(v1[2], v1[3]);
                *(u32x4*)rowp = w;
            }
    }
};

DI void transpose_item(const float* __restrict__ W, int N, bf16_t* __restrict__ WT, int K, int k0, int n0, int drow0, LAS float* scr, int lane) {
#pragma unroll 8
    for (int i = 0; i < 32; ++i) { const int kk = 2 * i + (lane >> 5); scr[kk * 33 + (lane & 31)] = W[(size_t)(k0 + kk) * N + n0 + (lane & 31)]; }
    lds_wait();
    const int c = lane & 7;
#pragma unroll
    for (int j = 0; j < 4; ++j) {
        const int n = (lane >> 3) + 8 * j; const LAS float* s = scr + (8 * c) * 33 + n;
        u32x4 o; o.x = pk2(s[0 * 33], s[1 * 33]); o.y = pk2(s[2 * 33], s[3 * 33]); o.z = pk2(s[4 * 33], s[5 * 33]); o.w = pk2(s[6 * 33], s[7 * 33]);
        *(u32x4*)(WT + (size_t)(drow0 + n) * K + k0 + 8 * c) = o;
    }
    lds_wait();
}
DI void transpose_matrix(const float* W, int K, int N, bf16_t* WT, int mode, LAS float* scr, int gw, int NGW, int lane) {
    const int nblk = N / 32, nitems = (K / 64) * nblk;
    for (int it = gw; it < nitems; it += NGW) {
        const int kb = it / nblk, nb = it % nblk, n0 = nb * 32;
        const int drow0 = mode == 0 ? n0 : ((n0 >> 7) * 256 + (n0 & 127) + (mode == 2 ? 128 : 0));
        transpose_item(W, N, WT, K, kb * 64, n0, drow0, scr, lane);
    }
}
DI void adaln_item(const Prm& p, LAS unsigned char* L, int item) {
    const int l = item / 96, cgp = item % 96;
    const int tid = opaque_tid(), wave = tid >> 6, lane = tid & 63;
    const float* cvec = p.in[5]; const float* cctx = p.in[6]; const float* w_ada = p.in[7]; const float* b_ada = p.in[8];
    float* MOD = (float*)(p.ws + WS_MOD);
    LAS float* SC = (LAS float*)L + wave * 256 * 12;
    for (int kk = lane; kk < 256; kk += 64) {
        const int k = wave * 256 + kk;
#pragma unroll
        for (int c = 0; c < 9; ++c) { const float v = c == 0 ? cctx[k] : cvec[(c - 1) * 2048 + k]; SC[kk * 12 + c] = siluf_(v); }
    }
    lds_wait();
    float acc[9][2];
#pragma unroll
    for (int c = 0; c < 9; ++c) { acc[c][0] = 0.f; acc[c][1] = 0.f; }
    const float* wp = w_ada + ((size_t)l * 2048 + wave * 256) * 12288 + cgp * 128 + 2 * lane;
#pragma unroll 8
    for (int kk = 0; kk < 256; ++kk) {
        const f32x2 w = *(const f32x2*)(wp + (size_t)kk * 12288);
        const f32x4 s0 = *(const LAS f32x4*)(SC + kk * 12), s1 = *(const LAS f32x4*)(SC + kk * 12 + 4); const float s8 = SC[kk * 12 + 8];
#pragma unroll
        for (int c = 0; c < 4; ++c) { acc[c][0] += s0[c] * w.x; acc[c][1] += s0[c] * w.y; acc[4 + c][0] += s1[c] * w.x; acc[4 + c][1] += s1[c] * w.y; }
        acc[8][0] += s8 * w.x; acc[8][1] += s8 * w.y;
    }
    __syncthreads();
    LAS float* RED = (LAS float*)L;
#pragma unroll
    for (int c = 0; c < 9; ++c) { RED[(wave * 9 + c) * 128 + 2 * lane] = acc[c][0]; RED[(wave * 9 + c) * 128 + 2 * lane + 1] = acc[c][1]; }
    __syncthreads();
    for (int idx = tid; idx < 9 * 128; idx += 512) {
        const int c = idx >> 7, col = idx & 127; float s = 0.f;
#pragma unroll
        for (int w = 0; w < 8; ++w) s += RED[(w * 9 + c) * 128 + col];
        MOD[((size_t)l * 9 + c) * 12288 + cgp * 128 + col] = s + b_ada[(size_t)l * 12288 + cgp * 128 + col];
    }
    __syncthreads();
}
DI void prologue_phase(const Prm& p, LAS unsigned char* L) {
    const int tid = opaque_tid(), wave = tid >> 6, lane = tid & 63;
    const int G = gridDim.x, gw = blockIdx.x * 8 + wave, NGW = G * 8;
    if (blockIdx.x == 0 && tid < 64) ((unsigned*)(p.ws + WS_FLG))[tid] = 0u;
    for (int it = blockIdx.x; it < 192; it += G) adaln_item(p, L, it);
    {
        const float* ck = p.in[2]; const float* cv = p.in[3];
        bf16_t* KC = (bf16_t*)(p.ws + WS_KC); bf16_t* VCT = (bf16_t*)(p.ws + WS_VCT);
        const int gt = blockIdx.x * 512 + tid, NT = G * 512;
        for (int ci = gt; ci < 524288; ci += NT) {
            const int row = ci >> 4, dc = ci & 15, bl = row >> 11, key = (row >> 2) & 511, h = row & 3;
            const f32x4 a = *(const f32x4*)(ck + (size_t)row * 128 + dc * 8), b = *(const f32x4*)(ck + (size_t)row * 128 + dc * 8 + 4);
            u32x4 o; o.x = pk2(a[0], a[1]); o.y = pk2(a[2], a[3]); o.z = pk2(b[0], b[1]); o.w = pk2(b[2], b[3]);
            *(u32x4*)(KC + ((size_t)((bl * 4 + h) * 512 + key)) * 128 + dc * 8) = o;
        }
        for (int ci = gt; ci < 524288; ci += NT) {
            const int d = ci & 127, kc = (ci >> 7) & 63, h = (ci >> 13) & 3, bl = ci >> 15;
            float v[8];
#pragma unroll
            for (int e = 0; e < 8; ++e) v[e] = cv[((size_t)(bl * 512 + kc * 8 + e) * 4 + h) * 128 + d];
            u32x4 o; o.x = pk2(v[0], v[1]); o.y = pk2(v[2], v[3]); o.z = pk2(v[4], v[5]); o.w = pk2(v[6], v[7]);
            *(u32x4*)(VCT + ((size_t)((bl * 4 + h) * 128 + d)) * 512 + kc * 8) = o;
        }
    }
    LAS float* scr = (LAS float*)L + wave * (64 * 33);
    for (int l = 0; l < 2; ++l) {
        transpose_matrix(p.in[10] + (size_t)l * D * NIN, D, NIN, (bf16_t*)(p.ws + WS_WIN) + (size_t)l * NIN * D, 0, scr, gw, NGW, lane);
        transpose_matrix(p.in[15] + (size_t)l * D * D, D, D, (bf16_t*)(p.ws + WS_WOUT) + (size_t)l * D * D, 0, scr, gw, NGW, lane);
        transpose_matrix(p.in[17] + (size_t)l * D * FF, D, FF, (bf16_t*)(p.ws + WS_WGU) + (size_t)l * NGU * D, 1, scr, gw, NGW, lane);
        transpose_matrix(p.in[18] + (size_t)l * D * FF, D, FF, (bf16_t*)(p.ws + WS_WGU) + (size_t)l * NGU * D, 2, scr, gw, NGW, lane);
        transpose_matrix(p.in[19] + (size_t)l * FF * D, FF, D, (bf16_t*)(p.ws + WS_WD) + (size_t)l * D * FF, 0, scr, gw, NGW, lane);
    }
}

DI void norm_phase(const Prm& p, int l, int which, bool copy_in) {
    const int tid = opaque_tid(), wave = tid >> 6, lane = tid & 63;
    const int gw = blockIdx.x * 8 + wave, NGW = gridDim.x * 8;
    float* X = (float*)(p.ws + WS_X); bf16_t* H = (bf16_t*)(p.ws + WS_H);
    const float* nw = which == 0 ? p.in[9] + l * D : (which == 1 ? p.in[16] + l * D : p.in[20]);
    const float* MOD = (const float*)(p.ws + WS_MOD) + (size_t)l * 9 * 12288 + (which == 1 ? 6144 : 0);
    const int rpw = (T + NGW - 1) / NGW, r_lo = gw * rpw, r_hi = min(T, r_lo + rpw);
    f32x4 cw[8], sh[8];
    int cur_cond = -1;
    for (int rb = r_lo; rb < r_hi; rb += 3) {
        {
            const int cond = rb < TP ? 0 : 1 + ((rb - TP) >> 10);
            if (cond != cur_cond) {
                cur_cond = cond;
                const float* shp = MOD + (size_t)cond * 12288; const float* scp = shp + 2048;
                f32x4 wv[8], sv[8];
#pragma unroll
                for (int j = 0; j < 8; ++j) { const int c = 4 * lane + 256 * j; wv[j] = *(const f32x4*)(nw + c); sv[j] = which == 2 ? (f32x4){0.f, 0.f, 0.f, 0.f} : *(const f32x4*)(scp + c); sh[j] = which == 2 ? (f32x4){0.f, 0.f, 0.f, 0.f} : *(const f32x4*)(shp + c); }
#pragma unroll
                for (int j = 0; j < 8; ++j) cw[j] = wv[j] * (1.f + sv[j]);
            }
        }
        f32x4 v[3][8];
#pragma unroll
        for (int q = 0; q < 3; ++q) {
            const int row = min(rb + q, r_hi - 1);
            const float* xr = copy_in ? (row < TP ? p.in[0] + (size_t)row * D : p.in[1] + (size_t)(row - TP) * D) : X + (size_t)row * D;
#pragma unroll
            for (int j = 0; j < 8; ++j) v[q][j] = *(const f32x4*)(xr + 4 * lane + 256 * j);
        }
#pragma unroll
        for (int q = 0; q < 3; ++q) {
            const int row = rb + q;
            if (row < r_hi) {
                const int cond = row < TP ? 0 : 1 + ((row - TP) >> 10);
                if (cond != cur_cond) {
                    cur_cond = cond;
                    const float* shp = MOD + (size_t)cond * 12288; const float* scp = shp + 2048;
#pragma unroll
                    for (int j = 0; j < 8; ++j) {
                        const int c = 4 * lane + 256 * j; const f32x4 w = *(const f32x4*)(nw + c);
                        if (which == 2) { cw[j] = w; sh[j] = (f32x4){0.f, 0.f, 0.f, 0.f}; }
                        else { cw[j] = w * (1.f + *(const f32x4*)(scp + c)); sh[j] = *(const f32x4*)(shp + c); }
                    }
                }
                float ss = 0.f;
#pragma unroll
                for (int j = 0; j < 8; ++j) ss += (v[q][j][0] * v[q][j][0] + v[q][j][1] * v[q][j][1]) + (v[q][j][2] * v[q][j][2] + v[q][j][3] * v[q][j][3]);
                ss = wave_sum(ss, lane);
                const float rstd = rsqrtf(ss * (1.f / D) + EPS);
                if (which == 2) {
#pragma unroll
                    for (int j = 0; j < 8; ++j) *(f32x4*)(p.out + O_Y + (size_t)row * D + 4 * lane + 256 * j) = v[q][j] * rstd * cw[j];
                } else {
#pragma unroll
                    for (int j = 0; j < 8; ++j) {
                        const f32x4 hv = (v[q][j] * rstd) * cw[j] + sh[j];
                        u32x2 o; o.x = pk2(hv[0], hv[1]); o.y = pk2(hv[2], hv[3]);
                        *(u32x2*)(H + (size_t)row * D + 4 * lane + 256 * j) = o;
                    }
                }
            }
        }
    }
}
DI void combine_phase(const Prm& p, int l) {
    const int tid = opaque_tid(), wave = tid >> 6, lane = tid & 63;
    const int gw = blockIdx.x * 8 + wave, NGW = gridDim.x * 8;
    const bf16_t* P = (const bf16_t*)(p.ws + WS_P); bf16_t* MIX = (bf16_t*)(p.ws + WS_MIX);
    const bf16_t* OF = (const bf16_t*)(p.ws + WS_OF); const bf16_t* OB = (const bf16_t*)(p.ws + WS_OB);
    const float* gw_ = p.in[12] + l * 128; const float* cwp = p.in[13] + (size_t)l * 3 * 512;
    const int v0 = (lane & 15) * 8, c0 = lane * 8;
    const f32x4 gw0 = *(const f32x4*)(gw_ + v0), gw1 = *(const f32x4*)(gw_ + v0 + 4);
    float cwt[3][8];
#pragma unroll
    for (int k = 0; k < 3; ++k)
#pragma unroll
        for (int e = 0; e < 8; ++e) cwt[k][e] = cwp[k * 512 + c0 + e];
    const int tpw = (T + NGW - 1) / NGW, t_lo = gw * tpw, t_hi = min(T, t_lo + tpw);
    const u32x4 zero = {0u, 0u, 0u, 0u};
    for (int tb = t_lo; tb < t_hi; tb += 2) {
        u32x4 a[2][2], bq[2][2]; u32x4 gg[2][2], cb[2], cc[2][3], cx[2][3];
#pragma unroll
        for (int q = 0; q < 2; ++q) {
            const int tok = min(tb + q, t_hi - 1);
            const bf16_t* pr = P + (size_t)tok * NIN;
#pragma unroll
            for (int ps = 0; ps < 2; ++ps) {
                const int col = (4 * ps + (lane >> 4)) * 128 + v0;
                a[q][ps] = *(const u32x4*)(OF + (size_t)tok * 1024 + col); bq[q][ps] = *(const u32x4*)(OB + (size_t)tok * 1024 + col);
                gg[q][ps] = *(const u32x4*)(pr + C_HG + col);
            }
            const int pos = tok < TP ? (tok & 255) : ((tok - TP) & 1023), len = tok < TP ? 256 : 1024;
            const bool hp = pos > 0, hn = pos < len - 1;
            cb[q] = *(const u32x4*)(pr + C_CB + c0);
            cc[q][1] = *(const u32x4*)(pr + C_CC + c0); cx[q][1] = *(const u32x4*)(pr + C_CX + c0);
            cc[q][0] = hp ? *(const u32x4*)(pr - NIN + C_CC + c0) : zero; cx[q][0] = hp ? *(const u32x4*)(pr - NIN + C_CX + c0) : zero;
            cc[q][2] = hn ? *(const u32x4*)(pr + NIN + C_CC + c0) : zero; cx[q][2] = hn ? *(const u32x4*)(pr + NIN + C_CX + c0) : zero;
        }
#pragma unroll
        for (int q = 0; q < 2; ++q) {
            const int tok = tb + q;
            if (tok < t_hi) {
#pragma unroll
                for (int ps = 0; ps < 2; ++ps) {
                    const int col = (4 * ps + (lane >> 4)) * 128 + v0;
                    const u32x4 af = a[q][ps], bf_ = bq[q][ps];
                    const f32x4 o0 = {bflo(af.x) + bflo(bf_.x), bfhi(af.x) + bfhi(bf_.x), bflo(af.y) + bflo(bf_.y), bfhi(af.y) + bfhi(bf_.y)};
                    const f32x4 o1 = {bflo(af.z) + bflo(bf_.z), bfhi(af.z) + bfhi(bf_.z), bflo(af.w) + bflo(bf_.w), bfhi(af.w) + bfhi(bf_.w)};
                    float ss = (o0[0] * o0[0] + o0[1] * o0[1]) + (o0[2] * o0[2] + o0[3] * o0[3]) + (o1[0] * o1[0] + o1[1] * o1[1]) + (o1[2] * o1[2] + o1[3] * o1[3]);
                    ss += shx(ss, 1, lane); ss += shx(ss, 2, lane); ss += shx(ss, 4, lane); ss += shx(ss, 8, lane);
                    const float rstd = rsqrtf(ss * (1.f / 128.f) + EPS);
                    const u32x4 g = gg[q][ps];
                    float r[8];
                    r[0] = o0[0] * rstd * gw0[0] * siluf_(bflo(g.x)); r[1] = o0[1] * rstd * gw0[1] * siluf_(bfhi(g.x));
                    r[2] = o0[2] * rstd * gw0[2] * siluf_(bflo(g.y)); r[3] = o0[3] * rstd * gw0[3] * siluf_(bfhi(g.y));
                    r[4] = o1[0] * rstd * gw1[0] * siluf_(bflo(g.z)); r[5] = o1[1] * rstd * gw1[1] * siluf_(bfhi(g.z));
                    r[6] = o1[2] * rstd * gw1[2] * siluf_(bflo(g.w)); r[7] = o1[3] * rstd * gw1[3] * siluf_(bfhi(g.w));
                    u32x4 o; o.x = pk2(r[0], r[1]); o.y = pk2(r[2], r[3]); o.z = pk2(r[4], r[5]); o.w = pk2(r[6], r[7]);
                    *(u32x4*)(MIX + (size_t)tok * D + col) = o;
                }
                float r[8];
#pragma unroll
                for (int e = 0; e < 4; ++e) {
                    r[2 * e] = bflo(cb[q][e]) * (bflo(cc[q][0][e]) * bflo(cx[q][0][e]) * cwt[0][2 * e] + bflo(cc[q][1][e]) * bflo(cx[q][1][e]) * cwt[1][2 * e] + bflo(cc[q][2][e]) * bflo(cx[q][2][e]) * cwt[2][2 * e]);
                    r[2 * e + 1] = bfhi(cb[q][e]) * (bfhi(cc[q][0][e]) * bfhi(cx[q][0][e]) * cwt[0][2 * e + 1] + bfhi(cc[q][1][e]) * bfhi(cx[q][1][e]) * cwt[1][2 * e + 1] + bfhi(cc[q][2][e]) * bfhi(cx[q][2][e]) * cwt[2][2 * e + 1]);
                }
                u32x4 o; o.x = pk2(r[0], r[1]); o.y = pk2(r[2], r[3]); o.z = pk2(r[4], r[5]); o.w = pk2(r[6], r[7]);
                *(u32x4*)(MIX + (size_t)tok * D + 1024 + c0) = o;
            }
        }
    }
}

template <int TG> DI void scan_consts(const LAS float* TOT, int lane, float E80, float (&Ceb)[2], float (&Cek)[2], float (&Aed)[2], float (&Aen)[2], float (&Gall)[2]) {
    float pre[2] = {1.f, 1.f}, post[2] = {1.f, 1.f}, mid[2] = {1.f, 1.f}, own[2] = {1.f, 1.f};
#pragma unroll
    for (int gq = 0; gq < 8; ++gq) {
        const f32x2 gt = *(const LAS f32x2*)(TOT + gq * 128 + 2 * lane);
        const bool inmid = TG >= 4 ? (gq >= 4 && gq < TG) : (gq > TG && gq <= 3);
#pragma unroll
        for (int ch = 0; ch < 2; ++ch) {
            const float gv = gt[ch];
            if (gq < TG) pre[ch] *= gv;
            if (gq > TG) post[ch] *= gv;
            if (inmid) mid[ch] *= gv;
            if (gq == TG) own[ch] = gv;
        }
    }
#pragma unroll
    for (int ch = 0; ch < 2; ++ch) {
        Ceb[ch] = pre[ch]; Cek[ch] = own[ch] * post[ch]; Gall[ch] = pre[ch] * own[ch] * post[ch];
        if (TG >= 4) { Aed[ch] = mid[ch]; Aen[ch] = fminf(__builtin_amdgcn_rcpf(mid[ch]), E80); }
        else { Aen[ch] = own[ch] * mid[ch]; Aed[ch] = fminf(__builtin_amdgcn_rcpf(Aen[ch]), E80); }
    }
}
constexpr int SC_QI = 0, SC_QP = 8448, SC_KP = SC_QP + 8704, SC_KHT = SC_KP + 8704, SC_VTS = SC_KHT + 10240, SC_EBL = SC_VTS + 10240, SC_TOT = SC_EBL + 512, SC_XCH = SC_TOT + 4096, SC_END = SC_XCH + 16384;
DI void scan_item(const Prm& p, LAS unsigned char* L, int l, int stream, int b, int h, int dir) {
    const int tid = opaque_tid(), lane = tid & 63;
    const int wave = __builtin_amdgcn_readfirstlane(tid >> 6), wq = wave & 3, kp = wave >> 2, tg = wave;
    const int N = stream ? 1024 : 256, row0 = stream ? TP + b * 1024 : b * 256;
    LAS unsigned char* QI = L + SC_QI; LAS unsigned char* QP = L + SC_QP; LAS unsigned char* KP = L + SC_KP; LAS unsigned char* KHT = L + SC_KHT; LAS unsigned char* VTS = L + SC_VTS;
    LAS float* EBL = (LAS float*)(L + SC_EBL); LAS float* TOT = (LAS float*)(L + SC_TOT); LAS float* XCH = (LAS float*)(L + SC_XCH);
    const bf16_t* P = (const bf16_t*)(p.ws + WS_P); const bf16_t* HIT = (const bf16_t*)(p.ws + WS_HIT);
    bf16_t* OO = (bf16_t*)(p.ws + (dir ? WS_OB : WS_OF));
    float lb[2] = {0.f, 0.f};
    if (l == 1) {
        const float* raw = p.in[11];
#pragma unroll
        for (int ch = 0; ch < 2; ++ch) { const int k = h * 128 + 2 * lane + ch; const float r0 = raw[(dir * 2 + 0) * 1024 + k], r1 = raw[(dir * 2 + 1) * 1024 + k]; lb[ch] = 1.f / (1.f + __expf(r0 - r1)); }
    }
    const int n31 = lane & 31, hh = lane >> 5, vcol = 32 * wq + n31;
    f32x16 S[4];
#pragma unroll
    for (int kt = 0; kt < 4; ++kt)
#pragma unroll
        for (int r = 0; r < 16; ++r) S[kt][r] = 0.f;
    if (stream) {
        const float* sp = p.in[4] + ((((size_t)b * 2 + l) * 2 + dir) * 8 + h) * 16384;
#pragma unroll
        for (int kt = 0; kt < 4; ++kt)
            if ((kt == 0) == (kp == 0)) {
#pragma unroll
                for (int r = 0; r < 16; ++r) S[kt][r] = sp[(32 * kt + crow(r, hh)) * 128 + vcol];
            }
    }
    const bf16_t* Pq = P + (size_t)row0 * NIN + C_HQ + h * 128 + 2 * lane;
    const bf16_t* Pf = P + (size_t)row0 * NIN + (dir ? C_HFB : C_HFF) + h * 128 + 2 * lane;
    const int vv = tid & 127, vp = tid >> 7;
    const bf16_t* Hv = HIT + (size_t)(h * 128 + vv) * T + row0;
    const int nchunk = N / 32, ostride = dir ? -1024 : 1024;
    unsigned xr[4], qr[4]; u32x4 va;
    auto load_chunk = [&](int c) {
#pragma unroll
        for (int t = 0; t < 4; ++t) {
            const int i = 32 * c + 4 * tg + t, tok = dir ? N - 1 - i : i;
            xr[t] = *(const unsigned*)(Pf + (size_t)tok * NIN); qr[t] = *(const unsigned*)(Pq + (size_t)tok * NIN);
        }
        va = *(const u32x4*)(dir ? Hv + N - 32 * c - 8 * vp - 8 : Hv + 32 * c + 8 * vp);
    };
    load_chunk(0);
    const float E80 = 5.5e34f;
    float c30 = 30.f; asm volatile("" : "+v"(c30));
    for (int c = 0; c < nchunk; ++c) {
        float lp[2][4], kk[2][4], qv[2][4];
#pragma unroll
        for (int t = 0; t < 4; ++t)
#pragma unroll
            for (int ch = 0; ch < 2; ++ch) {
                float x = ch ? bfhi(xr[t]) : bflo(xr[t]); qv[ch][t] = (ch ? bfhi(qr[t]) : bflo(qr[t])) * QSCALE;
                x = fminf(fmaxf(x, -c30), c30);
                const float e = __expf(-x), inv = __builtin_amdgcn_rcpf(1.f + e);
                lp[ch][t] = (1.f + lb[ch] * e) * inv;
                kk[ch][t] = (1.f - lb[ch]) * e * inv;
            }
#pragma unroll
        for (int ch = 0; ch < 2; ++ch) {
#pragma unroll
            for (int t = 1; t < 4; ++t) lp[ch][t] *= lp[ch][t - 1];
        }
        { f32x2 tt = {lp[0][3], lp[1][3]}; *(LAS f32x2*)(TOT + tg * 128 + 2 * lane) = tt; }
        {
            u32x4 w = va;
            if (dir) { w.x = (va.w >> 16) | (va.w << 16); w.y = (va.z >> 16) | (va.z << 16); w.z = (va.y >> 16) | (va.y << 16); w.w = (va.x >> 16) | (va.x << 16); }
            *(LAS u32x4*)(VTS + vv * 80 + 16 * vp) = w;
        }
        __syncthreads();
        float Ceb[2], Cek[2], Aed[2], Aen[2], Gall[2];
        switch (tg) {
            case 0: scan_consts<0>(TOT, lane, E80, Ceb, Cek, Aed, Aen, Gall); break;
            case 1: scan_consts<1>(TOT, lane, E80, Ceb, Cek, Aed, Aen, Gall); break;
            case 2: scan_consts<2>(TOT, lane, E80, Ceb, Cek, Aed, Aen, Gall); break;
            case 3: scan_consts<3>(TOT, lane, E80, Ceb, Cek, Aed, Aen, Gall); break;
            case 4: scan_consts<4>(TOT, lane, E80, Ceb, Cek, Aed, Aen, Gall); break;
            case 5: scan_consts<5>(TOT, lane, E80, Ceb, Cek, Aed, Aen, Gall); break;
            case 6: scan_consts<6>(TOT, lane, E80, Ceb, Cek, Aed, Aen, Gall); break;
            default: scan_consts<7>(TOT, lane, E80, Ceb, Cek, Aed, Aen, Gall); break;
        }
        float khv[2][4];
#pragma unroll
        for (int t = 0; t < 4; ++t) {
            const int ii = 4 * tg + t;
            float eb[2], ed[2], en[2];
#pragma unroll
            for (int ch = 0; ch < 2; ++ch) {
                const float l_ = lp[ch][t], rt = fminf(__builtin_amdgcn_rcpf(l_), E80);
                eb[ch] = l_ * Ceb[ch]; ed[ch] = l_ * Aed[ch]; en[ch] = fminf(rt * Aen[ch], E80);
                khv[ch][t] = kk[ch][t] * (rt * Cek[ch]);
            }
            *(LAS unsigned*)(QI + ii * 264 + 4 * lane) = pk2(qv[0][t] * eb[0], qv[1][t] * eb[1]);
            *(LAS unsigned*)(QP + ii * 272 + 4 * lane) = pk2(qv[0][t] * ed[0], qv[1][t] * ed[1]);
            *(LAS unsigned*)(KP + ii * 272 + 4 * lane) = pk2(kk[0][t] * en[0], kk[1][t] * en[1]);
        }
#pragma unroll
        for (int ch = 0; ch < 2; ++ch) { u32x2 w; w.x = pk2(khv[ch][0], khv[ch][1]); w.y = pk2(khv[ch][2], khv[ch][3]); *(LAS u32x2*)(KHT + (2 * lane + ch) * 80 + 8 * tg) = w; }
        if (tg == 0) { f32x2 e2 = {Gall[0], Gall[1]}; *(LAS f32x2*)(EBL + 2 * lane) = e2; }
        __syncthreads();
        if (c + 1 < nchunk) load_chunk(c + 1);
        f32x16 ao;
#pragma unroll
        for (int r = 0; r < 16; ++r) ao[r] = 0.f;
#pragma unroll
        for (int kt = 0; kt < 4; ++kt)
            if ((kt == 0) == (kp == 0)) {
#pragma unroll
                for (int s = 0; s < 2; ++s) {
                    const bf16x8 Bf = pack8(S[kt], s);
                    const int k0 = 32 * kt + 16 * s + 4 * hh;
                    const s16x4 lo = *(const LAS s16x4*)(QI + n31 * 264 + 2 * k0), hi = *(const LAS s16x4*)(QI + n31 * 264 + 2 * (k0 + 8));
                    ao = MFMA32(cat4(lo, hi), Bf, ao);
                }
            }
        if (kp == 0) {
            f32x16 X0, X1;
#pragma unroll
            for (int r = 0; r < 16; ++r) { X0[r] = 0.f; X1[r] = 0.f; }
#pragma unroll
            for (int ks = 0; ks < 8; ks += 2) {
                const bf16x8 A0 = *(const LAS bf16x8*)(KP + n31 * 272 + 2 * (16 * ks + 8 * hh)), B0 = *(const LAS bf16x8*)(QP + n31 * 272 + 2 * (16 * ks + 8 * hh));
                const bf16x8 A1 = *(const LAS bf16x8*)(KP + n31 * 272 + 2 * (16 * ks + 16 + 8 * hh)), B1 = *(const LAS bf16x8*)(QP + n31 * 272 + 2 * (16 * ks + 16 + 8 * hh));
                X0 = MFMA32(A0, B0, X0); X1 = MFMA32(A1, B1, X1);
            }
#pragma unroll
            for (int r = 0; r < 16; ++r) X0[r] = (crow(r, hh) <= n31) ? X0[r] + X1[r] : 0.f;
#pragma unroll
            for (int s = 0; s < 2; ++s) {
                const bf16x8 Af = pack8(X0, s);
                const int j0 = 16 * s + 4 * hh;
                const s16x4 lo = *(const LAS s16x4*)(VTS + vcol * 80 + 2 * j0), hi = *(const LAS s16x4*)(VTS + vcol * 80 + 2 * (j0 + 8));
                ao = MFMA32(Af, cat4(lo, hi), ao);
            }
        }
#pragma unroll
        for (int kt = 0; kt < 4; ++kt)
            if ((kt == 0) == (kp == 0)) {
#pragma unroll
                for (int g = 0; g < 4; ++g) {
                    const f32x4 e = *(const LAS f32x4*)(EBL + 32 * kt + 8 * g + 4 * hh);
#pragma unroll
                    for (int j = 0; j < 4; ++j) S[kt][4 * g + j] *= e[j];
                }
#pragma unroll
                for (int s = 0; s < 2; ++s) {
                    const bf16x8 Af = *(const LAS bf16x8*)(KHT + (32 * kt + n31) * 80 + 2 * (16 * s + 8 * hh));
                    const bf16x8 Bf = *(const LAS bf16x8*)(VTS + vcol * 80 + 2 * (16 * s + 8 * hh));
                    S[kt] = MFMA32(Af, Bf, S[kt]);
                }
            }
        if (kp == 1) {
#pragma unroll
            for (int g = 0; g < 4; ++g) { f32x4 v = {ao[4 * g], ao[4 * g + 1], ao[4 * g + 2], ao[4 * g + 3]}; *(LAS f32x4*)(XCH + wq * 1024 + g * 256 + lane * 4) = v; }
        }
        __syncthreads();
        if (kp == 0) {
            const int i0 = 32 * c + 4 * hh, tok0 = dir ? N - 1 - i0 : i0;
            bf16_t* ob = OO + (size_t)(row0 + tok0) * 1024 + h * 128 + vcol;
#pragma unroll
            for (int g = 0; g < 4; ++g) {
                const f32x4 v = *(const LAS f32x4*)(XCH + wq * 1024 + g * 256 + lane * 4);
#pragma unroll
                for (int j = 0; j < 4; ++j) ob[(j + 8 * g) * ostride] = f2bf(ao[4 * g + j] + v[j]);
            }
        }
    }
    if (!stream) {
        float* so = p.out + O_ST + ((((size_t)b * 2 + l) * 2 + dir) * 8 + h) * 16384;
#pragma unroll
        for (int kt = 0; kt < 4; ++kt)
            if ((kt == 0) == (kp == 0)) {
#pragma unroll
                for (int r = 0; r < 16; ++r) so[(32 * kt + crow(r, hh)) * 128 + vcol] = S[kt][r];
            }
    }
    __syncthreads();
}

constexpr int AT_KS = 0, AT_VS = 17408, AT_HALF = 35840, AT_RPB = 2 * AT_HALF, AT_END = AT_RPB + 4096;
constexpr float LOG2E = 1.4426950408889634f;
DI void attn_item(const Prm& p, LAS unsigned char* L, int l, int item) {
    const int tid = opaque_tid(), wave = tid >> 6, lane = tid & 63, kh = wave >> 2, qg = wave & 3, td = tid & 255;
    const int n16 = lane & 15, g = lane >> 4;
    float l2e_ = LOG2E; asm volatile("" : "+v"(l2e_));
    const bf16_t* P = (const bf16_t*)(p.ws + WS_P); const bf16_t* VT = (const bf16_t*)(p.ws + WS_VT);
    const bf16_t* KC = (const bf16_t*)(p.ws + WS_KC); const bf16_t* VCT = (const bf16_t*)(p.ws + WS_VCT);
    bf16_t* MIX = (bf16_t*)(p.ws + WS_MIX);
    const bool na = item >= 256;
    int b, h, qrow0, ntl, rq = 0, rs = 0;
    if (!na) { b = item >> 4; h = (item >> 2) & 3; qrow0 = b * 256 + (item & 3) * 64; ntl = 2; }
    else { const int it = item - 256; b = it >> 6; h = (it >> 4) & 3; rq = it & 15; qrow0 = TP + b * 1024 + rq * 64; ntl = 8; rs = min(max(rq - 4, 0), 8); }
    LAS unsigned char* KS = L + kh * AT_HALF + AT_KS; LAS unsigned char* VS = L + kh * AT_HALF + AT_VS;
    LAS float* RPB = (LAS float*)(L + AT_RPB) + 64;
    const bool band = na && kh == 0;
    unsigned vmask = 0xffffu; int dcb = 0, nt_lo = 0, nt_hi = 3;
    if (band) {
        const int qc = 16 * qg + n16, cs = min(max(qc - 8, 0), 48);
        vmask = 0u;
#pragma unroll
        for (int nt = 0; nt < 4; ++nt)
#pragma unroll
            for (int r = 0; r < 4; ++r) { const int kc = 16 * nt + 4 * g + r; if (kc >= cs && kc < cs + 16) vmask |= 1u << (4 * nt + r); }
        dcb = 4 * g - qc + 15;
        nt_lo = max(qg - 1, 0); nt_hi = min(qg + 1, 3);
    }
    bf16x8 Qf[4];
    { const bf16_t* qp = P + (size_t)(qrow0 + 16 * qg + n16) * NIN + C_NQ + h * 128 + 8 * g;
#pragma unroll
      for (int ks = 0; ks < 4; ++ks) Qf[ks] = *(const bf16x8*)(qp + 32 * ks); }
    f32x4 O[8];
#pragma unroll
    for (int dt = 0; dt < 8; ++dt) O[dt] = (f32x4){0.f, 0.f, 0.f, 0.f};
    float mrun = -1e30f, lsum = 0.f;
    u32x4 kr[4], vr[4];
    auto load_tile = [&](int t) {
        const bf16_t* ksrc; const bf16_t* vsrc; int ldk, ldv;
        if (!na) { const int kt = 2 * kh + t; ksrc = P + (size_t)(b * 256 + kt * 64) * NIN + C_NK + h * 128; ldk = NIN; vsrc = VT + (size_t)(h * 128) * T + b * 256 + kt * 64; ldv = T; }
        else if (kh == 0) { const int tr = TP + b * 1024 + (rs + t) * 64; ksrc = P + (size_t)tr * NIN + C_NK + h * 128; ldk = NIN; vsrc = VT + (size_t)(h * 128) * T + tr; ldv = T; }
        else { const size_t bh = (size_t)((b * 2 + l) * 4 + h); ksrc = KC + bh * 65536 + (size_t)t * 64 * 128; ldk = 128; vsrc = VCT + bh * 65536 + t * 64; ldv = 512; }
#pragma unroll
        for (int i = 0; i < 4; ++i) {
            const int id = td + 256 * i;
            kr[i] = *(const u32x4*)(ksrc + (size_t)(id >> 4) * ldk + (id & 15) * 8);
            vr[i] = *(const u32x4*)(vsrc + (size_t)(id >> 3) * ldv + (id & 7) * 8);
        }
    };
    load_tile(0);
    if (na) { const float* rp = p.in[14] + (size_t)(l * 4 + h) * 465; for (int i = tid; i < 465; i += 512) RPB[i] = rp[i]; }
    for (int t = 0; t < ntl; ++t) {
        __syncthreads();
#pragma unroll
        for (int i = 0; i < 4; ++i) {
            const int id = td + 256 * i;
            *(LAS u32x4*)(KS + (id >> 4) * 272 + (id & 15) * 16) = kr[i];
            *(LAS u32x4*)(VS + (id >> 3) * 144 + (id & 7) * 16) = vr[i];
        }
        __syncthreads();
        if (t + 1 < ntl) load_tile(t + 1);
        f32x4 Sx[4];
#pragma unroll
        for (int nt = 0; nt < 4; ++nt) {
            Sx[nt] = (f32x4){0.f, 0.f, 0.f, 0.f};
            if (nt >= nt_lo && nt <= nt_hi) {
#pragma unroll
                for (int ks = 0; ks < 4; ++ks) {
                    const bf16x8 Af = *(const LAS bf16x8*)(KS + (16 * nt + n16) * 272 + 2 * (32 * ks + 8 * g));
                    Sx[nt] = MFMA16(Af, Qf[ks], Sx[nt]);
                }
            }
        }
        if (band) {
            const LAS float* rb = RPB + (rs + t - rq + 7) * 31 + dcb;
#pragma unroll
            for (int nt = 0; nt < 4; ++nt)
#pragma unroll
                for (int r = 0; r < 4; ++r) Sx[nt][r] = ((vmask >> (4 * nt + r)) & 1u) ? Sx[nt][r] * QSCALE + rb[16 * nt + r] : -1e30f;
        } else {
#pragma unroll
            for (int nt = 0; nt < 4; ++nt) Sx[nt] = Sx[nt] * QSCALE;
        }
        float mx = -1e30f;
#pragma unroll
        for (int nt = 0; nt < 4; ++nt) mx = fmaxf(mx, fmaxf(fmaxf(Sx[nt][0], Sx[nt][1]), fmaxf(Sx[nt][2], Sx[nt][3])));
        if (__builtin_amdgcn_ballot_w64(mx > mrun + 8.f) != 0ull) {
            mx = fmaxf(mx, shx(mx, 16, lane)); mx = fmaxf(mx, shx(mx, 32, lane));
            const float mn = fmaxf(mrun, mx), alpha = __builtin_amdgcn_exp2f((mrun - mn) * l2e_);
            mrun = mn; lsum *= alpha;
#pragma unroll
            for (int dt = 0; dt < 8; ++dt) O[dt] = O[dt] * alpha;
        }
        const float mL = mrun * l2e_;
        unsigned pp[8];
#pragma unroll
        for (int nt = 0; nt < 4; ++nt) {
            float pv[4];
#pragma unroll
            for (int r = 0; r < 4; ++r) { pv[r] = __builtin_amdgcn_exp2f(Sx[nt][r] * l2e_ - mL); lsum += pv[r]; }
            pp[2 * nt] = pk2(pv[0], pv[1]); pp[2 * nt + 1] = pk2(pv[2], pv[3]);
        }
#pragma unroll
        for (int kk = 0; kk < 2; ++kk) {
            if (2 * kk + 1 >= nt_lo && 2 * kk <= nt_hi) {
                const u32x4 pb = {pp[4 * kk], pp[4 * kk + 1], pp[4 * kk + 2], pp[4 * kk + 3]};
                const bf16x8 Bf = __builtin_bit_cast(bf16x8, pb);
#pragma unroll
                for (int dt = 0; dt < 8; ++dt) {
                    const LAS unsigned char* vp = VS + (16 * dt + n16) * 144 + 2 * (32 * kk + 4 * g);
                    const s16x4 lo = *(const LAS s16x4*)vp, hi = *(const LAS s16x4*)(vp + 32);
                    O[dt] = MFMA16(cat4(lo, hi), Bf, O[dt]);
                }
            }
        }
    }
    lsum += shx(lsum, 16, lane); lsum += shx(lsum, 32, lane);
    __syncthreads();
    LAS float* MO = (LAS float*)L; LAS float* MM = (LAS float*)(L + 34048); LAS float* ML = MM + 64;
    const int q = 16 * qg + n16;
    if (kh == 1) {
#pragma unroll
        for (int dt = 0; dt < 8; ++dt) *(LAS f32x4*)(MO + q * 132 + 16 * dt + 4 * g) = O[dt];
        if (g == 0) { MM[q] = mrun; ML[q] = lsum; }
    }
    __syncthreads();
    if (kh == 0) {
        const float m1 = MM[q], l1 = ML[q], mn = fmaxf(mrun, m1), a0 = __builtin_amdgcn_exp2f((mrun - mn) * l2e_), a1 = __builtin_amdgcn_exp2f((m1 - mn) * l2e_);
        const float inv = 1.f / (lsum * a0 + l1 * a1);
        bf16_t* op = MIX + (size_t)(qrow0 + q) * D + 1536 + h * 128 + 4 * g;
#pragma unroll
        for (int dt = 0; dt < 8; ++dt) {
            const f32x4 o1 = *(const LAS f32x4*)(MO + q * 132 + 16 * dt + 4 * g);
            const f32x4 o = (O[dt] * a0 + o1 * a1) * inv;
            u32x2 w; w.x = pk2(o[0], o[1]); w.y = pk2(o[2], o[3]);
            *(u32x2*)(op + 16 * dt) = w;
        }
    }
    __syncthreads();
}

DI void mixer_phase(const Prm& p, LAS unsigned char* L, int l) {
    const int G = gridDim.x;
    unsigned* ctr = (unsigned*)(p.ws + WS_FLG) + l;
    LAS int* slot = (LAS int*)(L + LDS_BYTES - 16);
    int item = blockIdx.x;
    while (item < 1152) {
        int nxt_item = 0;
        if (threadIdx.x == 0) nxt_item = G + (int)__hip_atomic_fetch_add(ctr, 1u, __ATOMIC_RELAXED, __HIP_MEMORY_SCOPE_AGENT);
        if (item < 128) scan_item(p, L, l, 1, item >> 4, (item >> 1) & 7, item & 1);
        else if (item < 640) attn_item(p, L, l, 256 + (item - 128));
        else if (item < 896) { const int ix = item - 640; scan_item(p, L, l, 0, ix >> 4, (ix >> 1) & 7, ix & 1); }
        else attn_item(p, L, l, item - 896);
        if (threadIdx.x == 0) *slot = nxt_item;
        __syncthreads();
        item = *slot;
        __syncthreads();
    }
}

#ifndef PH_MASK
#define PH_MASK 0x3ff
#endif
#define PHASE_ON(bit) ((PH_MASK >> (bit)) & 1)
__global__ void __launch_bounds__(512, 2) mega_fwd(Prm p) {
    extern __shared__ __attribute__((aligned(16))) unsigned char lds_raw[];
    LAS unsigned char* L = (LAS unsigned char*)lds_raw;
    cg::grid_group grid = cg::this_grid();
    const int lo = p.ph_lo, hi = p.ph_hi;
    if (lo < 0) grid.sync();
    volatile LAS unsigned* xst = (volatile LAS unsigned*)(L + 131072);
    if (threadIdx.x < 2) xst[threadIdx.x] = 0u;
    __syncthreads();
    const XcdBarrier xb = xcd_barrier_post((unsigned*)(p.ws + WS_BAR), xst);
#define PH_BEGIN(n) if (lo <= (n) && (n) < hi) {
#define PH_END(n) if ((n) + 1 < hi) xcd_barrier(xb); }
    PH_BEGIN(0) if (PHASE_ON(0)) prologue_phase(p, L); PH_END(0)
#pragma nounroll
    for (int l = 0; l < 2; ++l) {
        const int pb = 1 + 8 * l;
        bf16_t* H = (bf16_t*)(p.ws + WS_H); bf16_t* MIX = (bf16_t*)(p.ws + WS_MIX); bf16_t* P = (bf16_t*)(p.ws + WS_P); float* X = (float*)(p.ws + WS_X);
        const float* MODl = (const float*)(p.ws + WS_MOD) + (size_t)l * 9 * 12288;
        PH_BEGIN(pb + 0) if (PHASE_ON(2)) norm_phase(p, l, 0, l == 0); PH_END(pb + 0)
        PH_BEGIN(pb + 1) if (PHASE_ON(3)) {
            pg8::StaticOrder S; pg8::Gemm g{H, (const bf16_t*)(p.ws + WS_WIN) + (size_t)l * NIN * D, T, NIN, D};
            EpiInProj E{P, (bf16_t*)(p.ws + WS_VT), (bf16_t*)(p.ws + WS_HIT), p.out + O_NK, p.out + O_NV, l};
            S.init(T, NIN, gridDim.x, blockIdx.x); pg8::gemm_phase<EpiInProj, pg8::StaticOrder>(L, g, S, E);
        } PH_END(pb + 1)
        PH_BEGIN(pb + 2) if (PHASE_ON(4)) mixer_phase(p, L, l); PH_END(pb + 2)
        PH_BEGIN(pb + 3) if (PHASE_ON(5)) combine_phase(p, l); PH_END(pb + 3)
        PH_BEGIN(pb + 4) if (PHASE_ON(6)) {
            pg8::HalfOrder<1> S; pg8::Gemm g{MIX, (const bf16_t*)(p.ws + WS_WOUT) + (size_t)l * D * D, T, D, D};
            EpiResid E{X, MODl + 4096, l == 0 ? p.in[0] : nullptr, l == 0 ? p.in[1] : nullptr};
            S.init(T, D, gridDim.x, blockIdx.x); pg8::gemm_phase<EpiResid, pg8::HalfOrder<1>>(L, g, S, E);
        } PH_END(pb + 4)
        PH_BEGIN(pb + 5) if (PHASE_ON(7)) norm_phase(p, l, 1, false); PH_END(pb + 5)
        PH_BEGIN(pb + 6) if (PHASE_ON(8)) {
            pg8::HalfOrder<2> S; pg8::Gemm g{H, (const bf16_t*)(p.ws + WS_WGU) + (size_t)l * NGU * D, T, NGU, D};
            EpiSwiGLU E{P};
            S.init(T, NGU, gridDim.x, blockIdx.x); pg8::gemm_phase<EpiSwiGLU, pg8::HalfOrder<2>>(L, g, S, E);
        } PH_END(pb + 6)
        PH_BEGIN(pb + 7) if (PHASE_ON(9)) {
            pg8::HalfOrder<1> S; pg8::Gemm g{P, (const bf16_t*)(p.ws + WS_WD) + (size_t)l * D * FF, T, D, FF};
            EpiResid E{X, MODl + 10240, nullptr, nullptr};
            S.init(T, D, gridDim.x, blockIdx.x); pg8::gemm_phase<EpiResid, pg8::HalfOrder<1>>(L, g, S, E);
        } PH_END(pb + 7)
    }
    PH_BEGIN(17) if (PHASE_ON(1)) norm_phase(p, 0, 2, false); PH_END(17)
}

extern "C" void kernel_launch(void* const* d_in, const int* in_sizes, int n_in, void* d_out, int out_size, void* d_ws, size_t ws_size, hipStream_t stream) {
    static int grid = 0;
    if (grid == 0) {
        if (n_in != 21 || ws_size < WS_END) { fprintf(stderr, "kernel_launch: need 21 inputs and %zu B of workspace; got %d, %zu\n", (size_t)WS_END, n_in, ws_size); grid = -1; return; }
        int dev = 0, cus = 0, per_cu = 0;
        hipGetDevice(&dev); hipDeviceGetAttribute(&cus, hipDeviceAttributeMultiprocessorCount, dev);
        if (hipFuncSetAttribute((const void*)mega_fwd, hipFuncAttributeMaxDynamicSharedMemorySize, LDS_BYTES) != hipSuccess) { fprintf(stderr, "kernel_launch: hipFuncSetAttribute failed\n"); grid = -1; return; }
        hipOccupancyMaxActiveBlocksPerMultiprocessor(&per_cu, (const void*)mega_fwd, 512, LDS_BYTES);
        (void)hipGetLastError();
        if (per_cu < 1) per_cu = 1;
        grid = cus * per_cu;
    }
    if (grid < 0) return;
    if (hipMemsetAsync((char*)d_ws + WS_FLG, 0, 4096 + 16384, stream) != hipSuccess) { fprintf(stderr, "kernel_launch: memset of control words failed\n"); return; }
    Prm p{};
    for (int i = 0; i < 21; ++i) p.in[i] = (const float*)d_in[i];
    p.out = (float*)d_out; p.ws = (unsigned char*)d_ws; p.ph_lo = 0; p.ph_hi = 18;
    void* args[] = {&p};
    hipError_t e = hipLaunchCooperativeKernel((const void*)mega_fwd, dim3(grid), dim3(512), args, LDS_BYTES, stream);
    if (e != hipSuccess) fprintf(stderr, "cooperative launch failed: %s (grid %d)\n", hipGetErrorString(e), grid);
}
```

```cpp
#include <hip/hip_runtime.h>
#include <hip/hip_cooperative_groups.h>
#include <cstdio>
#include <cstdint>
namespace cg = cooperative_groups;

#define DI __device__ __forceinline__
#define LAS __attribute__((address_space(3)))
typedef unsigned short bf16_t;
typedef short bf16x8 __attribute__((ext_vector_type(8)));
typedef short s16x4 __attribute__((ext_vector_type(4)));
typedef float f32x2 __attribute__((ext_vector_type(2)));
typedef float f32x4 __attribute__((ext_vector_type(4)));
typedef float f32x16 __attribute__((ext_vector_type(16)));
typedef unsigned u32x2 __attribute__((ext_vector_type(2)));
typedef unsigned u32x4 __attribute__((ext_vector_type(4)));
typedef __bf16 bfv2 __attribute__((ext_vector_type(2)));

constexpr int T = 12288, TP = 4096, D = 2048, NIN = 8192, FF = 5632, NGU = 11264;
constexpr float EPS = 1e-6f;
constexpr float QSCALE = 0.08838834764831845f;
constexpr int C_HQ = 0, C_HI = 1024, C_HFF = 2048, C_HFB = 3072, C_HG = 4096, C_CB = 5120, C_CC = 5632, C_CX = 6144, C_NQ = 6656, C_NK = 7168, C_NV = 7680;
constexpr size_t O_Y = 0, O_NK = (size_t)T * D, O_NV = O_NK + 4194304, O_ST = O_NV + 4194304;
constexpr size_t WS_X = 0;
constexpr size_t WS_H = WS_X + (size_t)T * D * 4;
constexpr size_t WS_MIX = WS_H + (size_t)T * D * 2;
constexpr size_t WS_P = WS_MIX + (size_t)T * D * 2;
constexpr size_t WS_OF = WS_P + (size_t)T * NIN * 2;
constexpr size_t WS_OB = WS_OF + (size_t)T * 1024 * 4;
constexpr size_t WS_VT = WS_OB + (size_t)T * 1024 * 4;
constexpr size_t WS_HIT = WS_VT + (size_t)512 * T * 2;
constexpr size_t WS_KC = WS_HIT + (size_t)1024 * T * 2;
constexpr size_t WS_VCT = WS_KC + (size_t)8 * 2 * 4 * 512 * 128 * 2;
constexpr size_t WS_WIN = WS_VCT + (size_t)8 * 2 * 4 * 512 * 128 * 2;
constexpr size_t WS_WOUT = WS_WIN + (size_t)2 * NIN * D * 2;
constexpr size_t WS_WGU = WS_WOUT + (size_t)2 * D * D * 2;
constexpr size_t WS_WD = WS_WGU + (size_t)2 * NGU * D * 2;
constexpr size_t WS_MOD = WS_WD + (size_t)2 * D * FF * 2;
constexpr size_t WS_FLG = WS_MOD + (size_t)2 * 9 * 12288 * 4;
constexpr size_t WS_BAR = WS_FLG + 4096;
constexpr size_t WS_END = WS_BAR + 16384;
constexpr int LDS_BYTES = 131072 + 64;

struct Prm { const float* in[21]; float* out; unsigned char* ws; int ph_lo, ph_hi; };

DI unsigned pk2(float lo, float hi) { f32x2 v = {lo, hi}; return __builtin_bit_cast(unsigned, __builtin_convertvector(v, bfv2)); }
DI bf16_t f2bf(float f) { return __builtin_bit_cast(unsigned short, (__bf16)f); }
DI float bf2f(bf16_t b) { return __uint_as_float(((unsigned)b) << 16); }
DI float bflo(unsigned w) { return __uint_as_float(w << 16); }
DI float bfhi(unsigned w) { return __uint_as_float(w & 0xffff0000u); }
DI float shx(float v, int o, int lane) { return __int_as_float(__builtin_amdgcn_ds_bpermute((lane ^ o) << 2, __float_as_int(v))); }
DI float wave_sum(float v, int lane) {
#pragma unroll
    for (int o = 1; o < 64; o <<= 1) v += shx(v, o, lane);
    return v;
}
DI void lds_wait() { asm volatile("s_waitcnt lgkmcnt(0)" ::: "memory"); }
DI float sigmoidf_(float x) { return __builtin_amdgcn_rcpf(1.f + __expf(-x)); }
DI float siluf_(float x) { return x * __builtin_amdgcn_rcpf(1.f + __expf(-x)); }
#define MFMA32(a, b, c) __builtin_amdgcn_mfma_f32_32x32x16_bf16((a), (b), (c), 0, 0, 0)
#define MFMA16(a, b, c) __builtin_amdgcn_mfma_f32_16x16x32_bf16((a), (b), (c), 0, 0, 0)
DI int crow(int reg, int h) { return (reg & 3) + 8 * (reg >> 2) + 4 * h; }
DI bf16x8 pack8(const f32x16& x, int s) {
    u32x4 p; p.x = pk2(x[8 * s], x[8 * s + 1]); p.y = pk2(x[8 * s + 2], x[8 * s + 3]); p.z = pk2(x[8 * s + 4], x[8 * s + 5]); p.w = pk2(x[8 * s + 6], x[8 * s + 7]);
    return __builtin_bit_cast(bf16x8, p);
}
DI bf16x8 cat4(s16x4 lo, s16x4 hi) { return __builtin_shufflevector(lo, hi, 0, 1, 2, 3, 4, 5, 6, 7); }

DI int opaque_tid() { int t = threadIdx.x; asm volatile("" : "+v"(t)); return t; }

#define XB_TMO      128
#define XB_XCNT(j)  (256  + 64 * (j))
#define XB_XSUB(j)  (1280 + 64 * (j))
#define XB_XGEN(j)  (2304 + 64 * (j))
#define XB_TOP      3328
#define XB_TOPGEN   3392
#define XCD_BAR_WORDS 3456
#define XB_SPIN_CAP (1u << 18)

__device__ __forceinline__ unsigned xb_ld(unsigned* p)              { return __hip_atomic_load(p, __ATOMIC_RELAXED, __HIP_MEMORY_SCOPE_AGENT); }
__device__ __forceinline__ unsigned xb_add(unsigned* p, unsigned v) { return __hip_atomic_fetch_add(p, v, __ATOMIC_RELAXED, __HIP_MEMORY_SCOPE_AGENT); }
__device__ __forceinline__ unsigned xb_xcc_id() { return (unsigned)__builtin_amdgcn_s_getreg((3 << 11) | 20) & 0xFu; }
#define XB_SPIN(cond, bar) do { unsigned _sp = 0; while (cond) { __builtin_amdgcn_s_sleep(1); \
    if ((++_sp & 255u) == 0u) { if (xb_ld(&(bar)[XB_TMO])) break; if (_sp > XB_SPIN_CAP) { atomicAdd(&(bar)[XB_TMO], 1u); break; } } } } while (0)

struct XcdBarrier {
    unsigned* bar; unsigned x;
    volatile LAS unsigned* st;
};

__device__ __forceinline__ XcdBarrier xcd_barrier_post(unsigned* bar, volatile LAS unsigned* st) {
    XcdBarrier b; b.bar = bar; b.x = xb_xcc_id(); b.st = st;
    if (threadIdx.x == 0) (void)xb_add(&bar[XB_XCNT(b.x)], 1u);
    return b;
}
__device__ __forceinline__ void xcd_barrier_complete(unsigned* bar, unsigned x, unsigned& nloc, unsigned& nx) {
    const unsigned G = gridDim.x * gridDim.y * gridDim.z;
    unsigned sum, cnt, mine, sp = 0u;
    for (;;) {
        sum = 0u; cnt = 0u; mine = 0u;
        unsigned cv[16];
#pragma unroll
        for (unsigned j = 0; j < 16; ++j) cv[j] = xb_ld(&bar[XB_XCNT(j)]);
#pragma unroll
        for (unsigned j = 0; j < 16; ++j) { const unsigned c = cv[j]; sum += c; cnt += (c > 0u) ? 1u : 0u; mine = (j == x) ? c : mine; }
        if (sum == G) break;
        __builtin_amdgcn_s_sleep(1);
        if ((++sp & 255u) == 0u) { if (xb_ld(&bar[XB_TMO])) break; if (sp > XB_SPIN_CAP) { atomicAdd(&bar[XB_TMO], 1u); break; } }
    }
    nloc = mine > 0u ? mine : 1u; nx = cnt > 0u ? cnt : 1u;
}

__device__ __forceinline__ void xcd_barrier(const XcdBarrier& b) {
    asm volatile("s_waitcnt vmcnt(0)" ::: "memory");
    __syncthreads();
    if (threadIdx.x == 0) {
        unsigned* bar = b.bar;
        __builtin_amdgcn_s_waitcnt(0);
        unsigned nloc = b.st[0], nx = b.st[1];
        if (nloc == 0u) { xcd_barrier_complete(bar, b.x, nloc, nx); b.st[0] = nloc; b.st[1] = nx; }
        const unsigned old = xb_add(&bar[XB_XSUB(b.x)], 1u);
        const unsigned gen = old / nloc;
        if (old + 1u == (gen + 1u) * nloc) {
            __builtin_amdgcn_fence(__ATOMIC_RELEASE, "agent");
            asm volatile("s_waitcnt vmcnt(0)" ::: "memory");
            const unsigned og = xb_add(&bar[XB_TOP], 1u);
            const unsigned tg = og / nx;
            if (og + 1u == (tg + 1u) * nx) xb_add(&bar[XB_TOPGEN], 1u);
            else XB_SPIN(xb_ld(&bar[XB_TOPGEN]) == tg, bar);
            __builtin_amdgcn_fence(__ATOMIC_ACQUIRE, "agent");
            xb_add(&bar[XB_XGEN(b.x)], 1u);
            asm volatile("s_waitcnt vmcnt(0)" ::: "memory");
        } else {
            XB_SPIN(xb_ld(&bar[XB_XGEN(b.x)]) == gen, bar);
            __builtin_amdgcn_fence(__ATOMIC_ACQUIRE, "agent");
            asm volatile("s_waitcnt vmcnt(0)" ::: "memory");
        }
    }
    __syncthreads();
}

namespace pg8 {
#define PG8_LAS __attribute__((address_space(3)))
constexpr int BM = 256, BK = 64, HALF = 128, HTB = HALF * BK * 2  , STAGE_BYTES = 8 * HTB, NXCD = 8, WGM = 4;

__host__ __device__ __forceinline__ int lds_byte(int r, int c) { const int st = (r >> 4) * 2 + (c >> 5), rr = r & 15, cc = c & 31, ob = rr * 64 + cc * 2; return st * 1024 + (ob ^ (((ob >> 9) & 1) << 5)); }
__host__ __device__ __forceinline__ void stage_rc(int b, int& R, int& C) { const int st = b / 1024, sb = b % 1024, swz = sb ^ (((sb >> 9) & 1) << 5); R = (st >> 1) * 16 + swz / 64; C = (st & 1) * 32 + (swz % 64) / 2; }
__host__ __device__ __forceinline__ int perm32(int rho) { const int n = rho >> 4, i = rho & 15; return 8 * (i >> 2) + 4 * n + (i & 3); }

struct Unit { int pm, pn, sp, kh; };
struct Gemm { const bf16_t* A; const bf16_t* Bt; int M, N, K; };

struct StaticOrder {
    int nM, nN, nwg, G, c;
    __host__ __device__ void init(int M, int N, int G_, int c_) { nM = M / BM; nN = N / BM; nwg = nM * nN; G = G_; c = c_; }
    __host__ __device__ void map(long L, Unit& u) const {
        int wgid = (int)L; { const int q = nwg / NXCD, r = nwg % NXCD, xcd = wgid % NXCD, off = wgid / NXCD; wgid = (xcd < r ? xcd * (q + 1) : r * (q + 1) + (xcd - r) * q) + off; }
        const int nig = WGM * nN, gid = wgid / nig, fm = gid * WGM, gsz = (nM - fm) < WGM ? (nM - fm) : WGM;
        u.pm = fm + ((wgid % nig) % gsz); u.pn = (wgid % nig) / gsz;
    }
    __host__ __device__ bool next(int i, Unit& u) const {
        const long L = (long)i * G + c; if (L >= nwg) return false;
        u.sp = 0; u.kh = 0; map(L, u); return true;
    }
    __device__ __forceinline__ void a_ready(const Unit&) const {}
    __device__ __forceinline__ void done(const Unit&) const {}
};

template <int KIND> struct HalfOrder : StaticOrder {
    __host__ __device__ bool next(int i, Unit& u) const {
        const int frnd = nwg / G, rem = nwg - frnd * G;
        u.sp = 0; u.kh = 0;
        if (i < frnd) { map((long)i * G + c, u); return true; }
        if (i > frnd || rem == 0) return false;
        if (2 * rem <= G) { if (c >= 2 * rem) return false; u.sp = KIND; u.kh = c & 1; map((long)frnd * G + (c >> 1), u); return true; }
        if (c >= rem) return false;
        map((long)frnd * G + c, u); return true;
    }
};

template <class Epi, class Sched>
__device__ __forceinline__ void gemm_phase(PG8_LAS unsigned char* lds, const Gemm g, const Sched& S, const Epi& E) {
    int tid_ = threadIdx.x; asm volatile("" : "+v"(tid_)); const int tid = tid_, wid = __builtin_amdgcn_readfirstlane(tid >> 6), lane = tid & 63, wr = wid >> 2, wc = wid & 3, fr = lane & 15, fq = lane >> 4;
    const int K = g.K, nt = K / BK;
    unsigned voffA[2], voffB[2];
#pragma unroll
    for (int i = 0; i < 2; ++i) { int R, C; stage_rc(tid * 16 + i * 8192, R, C); const int Rb = Epi::PERM ? ((R & ~31) + perm32(R & 31)) : R;
        voffA[i] = (unsigned)(R * K + C) * 2u; voffB[i] = (unsigned)(Rb * K + C) * 2u; }
    const size_t kstep = (size_t)(BK * 2);
    const size_t hstep = (size_t)HALF * K * 2;
    const size_t tstep = 2 * hstep;
    const unsigned ldsw = (unsigned)wid * 1024u;
    const int aoff = lds_byte(wr * 64 + fr, fq * 8), boff = lds_byte(wc * 32 + fr, fq * 8);
#define PG8_SA(b, h) (((b) * 2 + (h)) * HTB)
#define PG8_SB(b, h) ((4 + (b) * 2 + (h)) * HTB)
#define PG8_STAGE(bufoff, gbase, voff) do { _Pragma("unroll") for (int _i = 0; _i < 2; ++_i) \
        __builtin_amdgcn_global_load_lds((const unsigned*)((const char*)(gbase) + (voff)[_i]), (PG8_LAS unsigned*)(lds + (bufoff) + ldsw + _i * 8192), 16, 0, 0); } while (0)
#define PG8_LDA(dst, b, h) do { _Pragma("unroll") for (int m = 0; m < 4; ++m) _Pragma("unroll") for (int k = 0; k < 2; ++k) dst[m][k] = *(const PG8_LAS bf16x8*)(lds + PG8_SA(b, h) + aoff + m * 2048 + k * 1024); } while (0)
#define PG8_LDB(dst, b, h) do { _Pragma("unroll") for (int n = 0; n < 2; ++n) _Pragma("unroll") for (int k = 0; k < 2; ++k) dst[n][k] = *(const PG8_LAS bf16x8*)(lds + PG8_SB(b, h) + boff + n * 2048 + k * 1024); } while (0)
#define PG8_MMA(ai, bj, At, Bt) do { __builtin_amdgcn_s_setprio(1); _Pragma("unroll") for (int m = 0; m < 4; ++m) _Pragma("unroll") for (int n = 0; n < 2; ++n) _Pragma("unroll") for (int k = 0; k < 2; ++k) \
        acc[ai][bj][m][n] = __builtin_amdgcn_mfma_f32_16x16x32_bf16(Bt[n][k], At[m][k], acc[ai][bj][m][n], 0, 0, 0); __builtin_amdgcn_s_setprio(0); } while (0)
#define PG8_WAIT_V(n) asm volatile("s_waitcnt vmcnt(" #n ")" ::: "memory")
#define PG8_WAIT_L(n) asm volatile("s_waitcnt lgkmcnt(" #n ")" ::: "memory")
#define PG8_BAR __builtin_amdgcn_s_barrier()
#define PG8_SCHED __builtin_amdgcn_sched_barrier(0)
    Unit cur, nxt; int ui = 0;
    if (!S.next(0, cur)) return;
    f32x4 acc[2][2][4][2];
#pragma unroll
    for (int a = 0; a < 2; ++a)
#pragma unroll
        for (int b = 0; b < 2; ++b)
#pragma unroll
            for (int m = 0; m < 4; ++m)
#pragma unroll
                for (int n = 0; n < 2; ++n) acc[a][b][m][n] = (f32x4){0.f, 0.f, 0.f, 0.f};
    bf16x8 At[4][2], B0[2][2], B1[2][2];
    const char* cA = (const char*)g.A + (size_t)cur.pm * tstep + (cur.sp == 2 ? (size_t)cur.kh * hstep : 0); const char* cB = (const char*)g.Bt + (size_t)cur.pn * tstep + (cur.sp == 1 ? (size_t)cur.kh * hstep : 0);
    bool full = cur.sp != 1, fullm = cur.sp != 2;
    S.a_ready(cur);
    PG8_STAGE(PG8_SB(0, 0), cB, voffB); PG8_STAGE(PG8_SA(0, 0), cA, voffA); PG8_STAGE(PG8_SB(0, 1), cB + hstep, voffB); PG8_STAGE(PG8_SA(0, 1), cA + hstep, voffA);
    if (wr == 1) PG8_BAR;
    PG8_WAIT_V(4); PG8_BAR;
    PG8_STAGE(PG8_SB(1, 0), cB + kstep, voffB); PG8_STAGE(PG8_SA(1, 0), cA + kstep, voffA); PG8_STAGE(PG8_SB(1, 1), cB + hstep + kstep, voffB);
    PG8_WAIT_V(6); PG8_BAR;
    for (;;) {
        const bool has_next = S.next(ui + 1, nxt);
        const char* nA = has_next ? (const char*)g.A + (size_t)nxt.pm * tstep + (nxt.sp == 2 ? (size_t)nxt.kh * hstep : 0) : cA; const char* nB = has_next ? (const char*)g.Bt + (size_t)nxt.pn * tstep + (nxt.sp == 1 ? (size_t)nxt.kh * hstep : 0) : cB;
        for (int t = 0; t < nt; t += 2) {
            const bool last = (t == nt - 2);
            const char* a1 = cA + (size_t)(t + 1) * kstep;
            const char* a2 = last ? nA : cA + (size_t)(t + 2) * kstep; const char* b2 = last ? nB : cB + (size_t)(t + 2) * kstep;
            const char* a3 = a2 + kstep; const char* b3 = b2 + kstep;
            if (last && has_next) S.a_ready(nxt);
            PG8_LDB(B0, 0, 0); PG8_SCHED; PG8_LDA(At, 0, 0); PG8_STAGE(PG8_SA(1, 1), a1 + hstep, voffA);
            PG8_WAIT_L(8); PG8_BAR; PG8_WAIT_L(0); PG8_MMA(0, 0, At, B0); PG8_BAR; PG8_SCHED;
            if (full) PG8_LDB(B1, 0, 1); PG8_STAGE(PG8_SB(0, 0), b2, voffB);
            PG8_BAR; PG8_WAIT_L(0); if (full) PG8_MMA(0, 1, At, B1); PG8_BAR;
            if (fullm) PG8_LDA(At, 0, 1); PG8_STAGE(PG8_SA(0, 0), a2, voffA);
            PG8_BAR; PG8_WAIT_L(0); if (fullm) PG8_MMA(1, 0, At, B0); PG8_BAR; PG8_SCHED;
            PG8_STAGE(PG8_SB(0, 1), b2 + hstep, voffB);
            PG8_WAIT_V(6); PG8_BAR; if (full && fullm) PG8_MMA(1, 1, At, B1); PG8_BAR;
            PG8_LDB(B0, 1, 0); PG8_SCHED; PG8_LDA(At, 1, 0); PG8_STAGE(PG8_SA(0, 1), a2 + hstep, voffA);
            PG8_WAIT_L(8); PG8_BAR; PG8_WAIT_L(0); PG8_MMA(0, 0, At, B0); PG8_BAR; PG8_SCHED;
            if (full) PG8_LDB(B1, 1, 1); PG8_STAGE(PG8_SB(1, 0), b3, voffB);
            PG8_BAR; PG8_WAIT_L(0); if (full) PG8_MMA(0, 1, At, B1); PG8_BAR;
            if (fullm) PG8_LDA(At, 1, 1); PG8_STAGE(PG8_SA(1, 0), a3, voffA);
            PG8_BAR; PG8_WAIT_L(0); if (fullm) PG8_MMA(1, 0, At, B0); PG8_BAR; PG8_SCHED;
            PG8_STAGE(PG8_SB(1, 1), b3 + hstep, voffB);
            PG8_WAIT_V(6); PG8_BAR; if (full && fullm) PG8_MMA(1, 1, At, B1); PG8_BAR;
        }
        if constexpr (!Epi::AFTER_DRAIN) { E(acc, cur, wr, wc, fr, fq); S.done(cur); }
        if (!has_next) break;
#pragma unroll
        for (int a = 0; a < 2; ++a)
#pragma unroll
            for (int b = 0; b < 2; ++b)
#pragma unroll
                for (int m = 0; m < 4; ++m)
#pragma unroll
                    for (int n = 0; n < 2; ++n) acc[a][b][m][n] = (f32x4){0.f, 0.f, 0.f, 0.f};
        cur = nxt; cA = nA; cB = nB; ++ui; full = cur.sp != 1; fullm = cur.sp != 2;
    }
    PG8_WAIT_V(0);
    if (wr == 0) PG8_BAR;
    PG8_BAR;
    if constexpr (Epi::AFTER_DRAIN) { E.fused(acc, cur, wr, wc, fr, fq, lds, wid, lane); S.done(cur); }
#undef PG8_SA
#undef PG8_SB
#undef PG8_STAGE
#undef PG8_LDA
#undef PG8_LDB
#undef PG8_MMA
#undef PG8_WAIT_V
#undef PG8_WAIT_L
#undef PG8_BAR
#undef PG8_SCHED
}
}


struct EpiInProj {
    static constexpr bool PERM = true, AFTER_DRAIN = false;
    bf16_t* P; bf16_t* VT; bf16_t* HIT; float* out_k; float* out_v; int layer;
    DI void operator()(const f32x4 (&acc)[2][2][4][2], const pg8::Unit& u, int wr, int wc, int fr, int fq) const {
        const int row0 = u.pm * 256 + wr * 64 + fr, col0 = u.pn * 256 + wc * 32 + 8 * fq;
        const bool skip_p = (u.pn >= 4 && u.pn < 8) || (u.pn >= 30);
#pragma unroll
        for (int ai = 0; ai < 2; ++ai)
#pragma unroll
            for (int m = 0; m < 4; ++m) {
                bf16_t* rowp = P + (size_t)(row0 + ai * 128 + m * 16) * NIN + col0;
                if (!skip_p)
#pragma unroll
                for (int bj = 0; bj < 2; ++bj) {
                    const f32x4 a0 = acc[ai][bj][m][0], a1 = acc[ai][bj][m][1];
                    u32x4 w; w.x = pk2(a0[0], a0[1]); w.y = pk2(a0[2], a0[3]); w.z = pk2(a1[0], a1[1]); w.w = pk2(a1[2], a1[3]);
                    *(u32x4*)(rowp + bj * 128) = w;
                }
            }
        const bool is_hi = (u.pn >= 4 && u.pn < 8), is_nv = (u.pn >= 30);
        if (is_hi || is_nv) {
            bf16_t* TB = is_hi ? HIT : VT;
            const int cb = u.pn * 256 - (is_hi ? C_HI : C_NV) + wc * 32 + 8 * fq;
#pragma unroll
            for (int ai = 0; ai < 2; ++ai)
#pragma unroll
                for (int m = 0; m < 4; ++m) {
                    const int row = row0 + ai * 128 + m * 16;
#pragma unroll
                    for (int bj = 0; bj < 2; ++bj)
#pragma unroll
                        for (int n = 0; n < 2; ++n)
#pragma unroll
                            for (int j = 0; j < 4; ++j) TB[(size_t)(cb + bj * 128 + 4 * n + j) * T + row] = f2bf(acc[ai][bj][m][n][j]);
                }
        }
        if (u.pm < 16 && u.pn >= 28) {
            float* dst = (u.pn < 30) ? out_k : out_v;
            const int cb = u.pn * 256 - (u.pn < 30 ? C_NK : C_NV) + wc * 32 + 8 * fq;
#pragma unroll
            for (int ai = 0; ai < 2; ++ai)
#pragma unroll
                for (int m = 0; m < 4; ++m) {
                    const int row = row0 + ai * 128 + m * 16, b = row >> 8, s = row & 255;
                    float* rp = dst + ((size_t)((b * 2 + layer) * 256 + s)) * 512 + cb;
#pragma unroll
                    for (int bj = 0; bj < 2; ++bj) { *(f32x4*)(rp + bj * 128) = acc[ai][bj][m][0]; *(f32x4*)(rp + bj * 128 + 4) = acc[ai][bj][m][1]; }
                }
        }
    }
};
struct EpiResid {
    static constexpr bool PERM = false, AFTER_DRAIN = false;
    float* X; const float* gate; const float* xp; const float* xs;
    DI void operator()(const f32x4 (&acc)[2][2][4][2], const pg8::Unit& u, int wr, int wc, int fr, int fq) const {
        const int cond = u.pm < 16 ? 0 : 1 + ((u.pm - 16) >> 2);
        const int row0 = u.pm * 256 + wr * 64 + fr;
        const float* src = xp ? (u.pm < 16 ? xp : xs - (size_t)TP * D) : X;
        if (u.sp) {
            const int col0 = u.pn * 256 + u.kh * 128 + wc * 32 + 4 * fq;
            const float* gp = gate + (size_t)cond * 12288 + col0;
            const f32x4 g0 = *(const f32x4*)gp, g1 = *(const f32x4*)(gp + 16);
#pragma unroll
            for (int ai = 0; ai < 2; ++ai) {
                f32x4 xb[4][2];
#pragma unroll
                for (int m = 0; m < 4; ++m) {
                    const float* sp_ = src + (size_t)(row0 + ai * 128 + m * 16) * D + col0;
                    xb[m][0] = *(const f32x4*)sp_; xb[m][1] = *(const f32x4*)(sp_ + 16);
                }
#pragma unroll
                for (int m = 0; m < 4; ++m) {
                    float* dp = X + (size_t)(row0 + ai * 128 + m * 16) * D + col0;
                    *(f32x4*)dp = xb[m][0] + g0 * acc[ai][0][m][0]; *(f32x4*)(dp + 16) = xb[m][1] + g1 * acc[ai][0][m][1];
                }
            }
            return;
        }
        const int col0 = u.pn * 256 + wc * 32 + 4 * fq;
        const float* gp = gate + (size_t)cond * 12288 + col0;
        f32x4 gv[4];
#pragma unroll
        for (int q = 0; q < 4; ++q) gv[q] = *(const f32x4*)(gp + (q >> 1) * 128 + (q & 1) * 16);
#pragma unroll
        for (int hb = 0; hb < 3; ++hb) {
            const int r0 = 3 * hb, nr = hb < 2 ? 3 : 2;
            f32x4 xb[3][4];
#pragma unroll
            for (int rr = 0; rr < 3; ++rr)
                if (rr < nr) {
                    const int r = r0 + rr;
#pragma unroll
                    for (int q = 0; q < 4; ++q) xb[rr][q] = *(const f32x4*)(src + (size_t)(row0 + (r >> 2) * 128 + (r & 3) * 16) * D + col0 + (q >> 1) * 128 + (q & 1) * 16);
                }
#pragma unroll
            for (int rr = 0; rr < 3; ++rr)
                if (rr < nr) {
                    const int r = r0 + rr;
#pragma unroll
                    for (int q = 0; q < 4; ++q)
                        *(f32x4*)(X + (size_t)(row0 + (r >> 2) * 128 + (r & 3) * 16) * D + col0 + (q >> 1) * 128 + (q & 1) * 16) = xb[rr][q] + gv[q] * acc[r >> 2][q >> 1][r & 3][q & 1];
                }
        }
    }
};
struct EpiSwiGLU {
    static constexpr bool PERM = true, AFTER_DRAIN = false;
    bf16_t* U;
    DI void operator()(const f32x4 (&acc)[2][2][4][2], const pg8::Unit& u, int wr, int wc, int fr, int fq) const {
        const int row0 = u.pm * 256 + (u.sp == 2 ? u.kh * 128 : 0) + wr * 64 + fr, col0 = u.pn * 128 + wc * 32 + 8 * fq;
#pragma unroll
        for (int ai = 0; ai < 2; ++ai)
            if (ai == 0 || u.sp != 2)
#pragma unroll
            for (int m = 0; m < 4; ++m) {
                bf16_t* rowp = U + (size_t)(row0 + ai * 128 + m * 16) * FF + col0;
                f32x4 v0, v1;
#pragma unroll
                for (int j = 0; j < 4; ++j) { v0[j] = siluf_(acc[ai][0][m][0][j]) * acc[ai][1][m][0][j]; v1[j] = siluf_(acc[ai][0][m][1][j]) * acc[ai][1][m][1][j]; }
                u32x4 w; w.x = pk2(v0[0], v0[1]); w.y = pk2(v0[2], v0[3]); w.z = pk2(v1[0], v1[1]); w.w = pk2(v1[2], v1[3]);
                *(u32x4*)rowp = w;
            }
    }
};

DI void transpose_item(const float* __restrict__ W, int N, bf16_t* __restrict__ WT, int K, int k0, int n0, int drow0, LAS float* scr, int lane) {
#pragma unroll 8
    for (int i = 0; i < 32; ++i) { const int kk = 2 * i + (lane >> 5); scr[kk * 33 + (lane & 31)] = W[(size_t)(k0 + kk) * N + n0 + (lane & 31)]; }
    lds_wait();
    const int c = lane & 7;
#pragma unroll
    for (int j = 0; j < 4; ++j) {
        const int n = (lane >> 3) + 8 * j; const LAS float* s = scr + (8 * c) * 33 + n;
        u32x4 o; o.x = pk2(s[0 * 33], s[1 * 33]); o.y = pk2(s[2 * 33], s[3 * 33]); o.z = pk2(s[4 * 33], s[5 * 33]); o.w = pk2(s[6 * 33], s[7 * 33]);
        *(u32x4*)(WT + (size_t)(drow0 + n) * K + k0 + 8 * c) = o;
    }
    lds_wait();
}
DI void transpose_matrix(const float* W, int K, int N, bf16_t* WT, int mode, LAS float* scr, int gw, int NGW, int lane) {
    const int nblk = N / 32, nitems = (K / 64) * nblk;
    for (int it = gw; it < nitems; it += NGW) {
        const int kb = it / nblk, nb = it % nblk, n0 = nb * 32;
        const int drow0 = mode == 0 ? n0 : ((n0 >> 7) * 256 + (n0 & 127) + (mode == 2 ? 128 : 0));
        transpose_item(W, N, WT, K, kb * 64, n0, drow0, scr, lane);
    }
}
DI void adaln_item(const Prm& p, LAS unsigned char* L, int item) {
    const int l = item / 96, cgp = item % 96;
    const int tid = opaque_tid(), wave = tid >> 6, lane = tid & 63;
    const float* cvec = p.in[5]; const float* cctx = p.in[6]; const float* w_ada = p.in[7]; const float* b_ada = p.in[8];
    float* MOD = (float*)(p.ws + WS_MOD);
    LAS float* SC = (LAS float*)L + wave * 256 * 12;
    for (int kk = lane; kk < 256; kk += 64) {
        const int k = wave * 256 + kk;
#pragma unroll
        for (int c = 0; c < 9; ++c) { const float v = c == 0 ? cctx[k] : cvec[(c - 1) * 2048 + k]; SC[kk * 12 + c] = siluf_(v); }
    }
    lds_wait();
    float acc[9][2];
#pragma unroll
    for (int c = 0; c < 9; ++c) { acc[c][0] = 0.f; acc[c][1] = 0.f; }
    const float* wp = w_ada + ((size_t)l * 2048 + wave * 256) * 12288 + cgp * 128 + 2 * lane;
#pragma unroll 8
    for (int kk = 0; kk < 256; ++kk) {
        const f32x2 w = *(const f32x2*)(wp + (size_t)kk * 12288);
        const f32x4 s0 = *(const LAS f32x4*)(SC + kk * 12), s1 = *(const LAS f32x4*)(SC + kk * 12 + 4); const float s8 = SC[kk * 12 + 8];
#pragma unroll
        for (int c = 0; c < 4; ++c) { acc[c][0] += s0[c] * w.x; acc[c][1] += s0[c] * w.y; acc[4 + c][0] += s1[c] * w.x; acc[4 + c][1] += s1[c] * w.y; }
        acc[8][0] += s8 * w.x; acc[8][1] += s8 * w.y;
    }
    __syncthreads();
    LAS float* RED = (LAS float*)L;
#pragma unroll
    for (int c = 0; c < 9; ++c) { RED[(wave * 9 + c) * 128 + 2 * lane] = acc[c][0]; RED[(wave * 9 + c) * 128 + 2 * lane + 1] = acc[c][1]; }
    __syncthreads();
    for (int idx = tid; idx < 9 * 128; idx += 512) {
        const int c = idx >> 7, col = idx & 127; float s = 0.f;
#pragma unroll
        for (int w = 0; w < 8; ++w) s += RED[(w * 9 + c) * 128 + col];
        MOD[((size_t)l * 9 + c) * 12288 + cgp * 128 + col] = s + b_ada[(size_t)l * 12288 + cgp * 128 + col];
    }
    __syncthreads();
}
DI void prologue_phase(const Prm& p, LAS unsigned char* L) {
    const int tid = opaque_tid(), wave = tid >> 6, lane = tid & 63;
    const int G = gridDim.x, gw = blockIdx.x * 8 + wave, NGW = G * 8;
    if (blockIdx.x == 0 && tid < 64) ((unsigned*)(p.ws + WS_FLG))[tid] = 0u;
    for (int it = blockIdx.x; it < 192; it += G) adaln_item(p, L, it);
    {
        const float* ck = p.in[2]; const float* cv = p.in[3];
        bf16_t* KC = (bf16_t*)(p.ws + WS_KC); bf16_t* VCT = (bf16_t*)(p.ws + WS_VCT);
        const int gt = blockIdx.x * 512 + tid, NT = G * 512;
        for (int ci = gt; ci < 524288; ci += NT) {
            const int row = ci >> 4, dc = ci & 15, bl = row >> 11, key = (row >> 2) & 511, h = row & 3;
            const f32x4 a = *(const f32x4*)(ck + (size_t)row * 128 + dc * 8), b = *(const f32x4*)(ck + (size_t)row * 128 + dc * 8 + 4);
            u32x4 o; o.x = pk2(a[0], a[1]); o.y = pk2(a[2], a[3]); o.z = pk2(b[0], b[1]); o.w = pk2(b[2], b[3]);
            *(u32x4*)(KC + ((size_t)((bl * 4 + h) * 512 + key)) * 128 + dc * 8) = o;
        }
        for (int ci = gt; ci < 524288; ci += NT) {
            const int d = ci & 127, kc = (ci >> 7) & 63, h = (ci >> 13) & 3, bl = ci >> 15;
            float v[8];
#pragma unroll
            for (int e = 0; e < 8; ++e) v[e] = cv[((size_t)(bl * 512 + kc * 8 + e) * 4 + h) * 128 + d];
            u32x4 o; o.x = pk2(v[0], v[1]); o.y = pk2(v[2], v[3]); o.z = pk2(v[4], v[5]); o.w = pk2(v[6], v[7]);
            *(u32x4*)(VCT + ((size_t)((bl * 4 + h) * 128 + d)) * 512 + kc * 8) = o;
        }
    }
    LAS float* scr = (LAS float*)L + wave * (64 * 33);
    for (int l = 0; l < 2; ++l) {
        transpose_matrix(p.in[10] + (size_t)l * D * NIN, D, NIN, (bf16_t*)(p.ws + WS_WIN) + (size_t)l * NIN * D, 0, scr, gw, NGW, lane);
        transpose_matrix(p.in[15] + (size_t)l * D * D, D, D, (bf16_t*)(p.ws + WS_WOUT) + (size_t)l * D * D, 0, scr, gw, NGW, lane);
        transpose_matrix(p.in[17] + (size_t)l * D * FF, D, FF, (bf16_t*)(p.ws + WS_WGU) + (size_t)l * NGU * D, 1, scr, gw, NGW, lane);
        transpose_matrix(p.in[18] + (size_t)l * D * FF, D, FF, (bf16_t*)(p.ws + WS_WGU) + (size_t)l * NGU * D, 2, scr, gw, NGW, lane);
        transpose_matrix(p.in[19] + (size_t)l * FF * D, FF, D, (bf16_t*)(p.ws + WS_WD) + (size_t)l * D * FF, 0, scr, gw, NGW, lane);
    }
}

DI void norm_phase(const Prm& p, int l, int which, bool copy_in) {
    const int tid = opaque_tid(), wave = tid >> 6, lane = tid & 63;
    const int gw = blockIdx.x * 8 + wave, NGW = gridDim.x * 8;
    float* X = (float*)(p.ws + WS_X); bf16_t* H = (bf16_t*)(p.ws + WS_H);
    const float* nw = which == 0 ? p.in[9] + l * D : (which == 1 ? p.in[16] + l * D : p.in[20]);
    const float* MOD = (const float*)(p.ws + WS_MOD) + (size_t)l * 9 * 12288 + (which == 1 ? 6144 : 0);
    const int rpw = (T + NGW - 1) / NGW, r_lo = gw * rpw, r_hi = min(T, r_lo + rpw);
    f32x4 cw[8], sh[8];
    int cur_cond = -1;
    for (int rb = r_lo; rb < r_hi; rb += 3) {
        {
            const int cond = rb < TP ? 0 : 1 + ((rb - TP) >> 10);
            if (cond != cur_cond) {
                cur_cond = cond;
                const float* shp = MOD + (size_t)cond * 12288; const float* scp = shp + 2048;
                f32x4 wv[8], sv[8];
#pragma unroll
                for (int j = 0; j < 8; ++j) { const int c = 4 * lane + 256 * j; wv[j] = *(const f32x4*)(nw + c); sv[j] = which == 2 ? (f32x4){0.f, 0.f, 0.f, 0.f} : *(const f32x4*)(scp + c); sh[j] = which == 2 ? (f32x4){0.f, 0.f, 0.f, 0.f} : *(const f32x4*)(shp + c); }
#pragma unroll
                for (int j = 0; j < 8; ++j) cw[j] = wv[j] * (1.f + sv[j]);
            }
        }
        f32x4 v[3][8];
#pragma unroll
        for (int q = 0; q < 3; ++q) {
            const int row = min(rb + q, r_hi - 1);
            const float* xr = copy_in ? (row < TP ? p.in[0] + (size_t)row * D : p.in[1] + (size_t)(row - TP) * D) : X + (size_t)row * D;
#pragma unroll
            for (int j = 0; j < 8; ++j) v[q][j] = *(const f32x4*)(xr + 4 * lane + 256 * j);
        }
#pragma unroll
        for (int q = 0; q < 3; ++q) {
            const int row = rb + q;
            if (row < r_hi) {
                const int cond = row < TP ? 0 : 1 + ((row - TP) >> 10);
                if (cond != cur_cond) {
                    cur_cond = cond;
                    const float* shp = MOD + (size_t)cond * 12288; const float* scp = shp + 2048;
#pragma unroll
                    for (int j = 0; j < 8; ++j) {
                        const int c = 4 * lane + 256 * j; const f32x4 w = *(const f32x4*)(nw + c);
                        if (which == 2) { cw[j] = w; sh[j] = (f32x4){0.f, 0.f, 0.f, 0.f}; }
                        else { cw[j] = w * (1.f + *(const f32x4*)(scp + c)); sh[j] = *(const f32x4*)(shp + c); }
                    }
                }
                float ss = 0.f;
#pragma unroll
                for (int j = 0; j < 8; ++j) ss += (v[q][j][0] * v[q][j][0] + v[q][j][1] * v[q][j][1]) + (v[q][j][2] * v[q][j][2] + v[q][j][3] * v[q][j][3]);
                ss = wave_sum(ss, lane);
                const float rstd = rsqrtf(ss * (1.f / D) + EPS);
                if (which == 2) {
#pragma unroll
                    for (int j = 0; j < 8; ++j) *(f32x4*)(p.out + O_Y + (size_t)row * D + 4 * lane + 256 * j) = v[q][j] * rstd * cw[j];
                } else {
#pragma unroll
                    for (int j = 0; j < 8; ++j) {
                        const f32x4 hv = (v[q][j] * rstd) * cw[j] + sh[j];
                        u32x2 o; o.x = pk2(hv[0], hv[1]); o.y = pk2(hv[2], hv[3]);
                        *(u32x2*)(H + (size_t)row * D + 4 * lane + 256 * j) = o;
                    }
                }
            }
        }
    }
}
DI void combine_phase(const Prm& p, int l) {
    const int tid = opaque_tid(), wave = tid >> 6, lane = tid & 63;
    const int gw = blockIdx.x * 8 + wave, NGW = gridDim.x * 8;
    const bf16_t* P = (const bf16_t*)(p.ws + WS_P); bf16_t* MIX = (bf16_t*)(p.ws + WS_MIX);
    const bf16_t* OF = (const bf16_t*)(p.ws + WS_OF); const bf16_t* OB = (const bf16_t*)(p.ws + WS_OB);
    const float* gw_ = p.in[12] + l * 128; const float* cwp = p.in[13] + (size_t)l * 3 * 512;
    const int v0 = (lane & 15) * 8, c0 = lane * 8;
    const f32x4 gw0 = *(const f32x4*)(gw_ + v0), gw1 = *(const f32x4*)(gw_ + v0 + 4);
    float cwt[3][8];
#pragma unroll
    for (int k = 0; k < 3; ++k)
#pragma unroll
        for (int e = 0; e < 8; ++e) cwt[k][e] = cwp[k * 512 + c0 + e];
    const int tpw = (T + NGW - 1) / NGW, t_lo = gw * tpw, t_hi = min(T, t_lo + tpw);
    const u32x4 zero = {0u, 0u, 0u, 0u};
    for (int tb = t_lo; tb < t_hi; tb += 2) {
        u32x4 a[2][2], bq[2][2]; u32x4 gg[2][2], cb[2], cc[2][3], cx[2][3];
#pragma unroll
        for (int q = 0; q < 2; ++q) {
            const int tok = min(tb + q, t_hi - 1);
            const bf16_t* pr = P + (size_t)tok * NIN;
#pragma unroll
            for (int ps = 0; ps < 2; ++ps) {
                const int col = (4 * ps + (lane >> 4)) * 128 + v0;
                a[q][ps] = *(const u32x4*)(OF + (size_t)tok * 1024 + col); bq[q][ps] = *(const u32x4*)(OB + (size_t)tok * 1024 + col);
                gg[q][ps] = *(const u32x4*)(pr + C_HG + col);
            }
            const int pos = tok < TP ? (tok & 255) : ((tok - TP) & 1023), len = tok < TP ? 256 : 1024;
            const bool hp = pos > 0, hn = pos < len - 1;
            cb[q] = *(const u32x4*)(pr + C_CB + c0);
            cc[q][1] = *(const u32x4*)(pr + C_CC + c0); cx[q][1] = *(const u32x4*)(pr + C_CX + c0);
            cc[q][0] = hp ? *(const u32x4*)(pr - NIN + C_CC + c0) : zero; cx[q][0] = hp ? *(const u32x4*)(pr - NIN + C_CX + c0) : zero;
            cc[q][2] = hn ? *(const u32x4*)(pr + NIN + C_CC + c0) : zero; cx[q][2] = hn ? *(const u32x4*)(pr + NIN + C_CX + c0) : zero;
        }
#pragma unroll
        for (int q = 0; q < 2; ++q) {
            const int tok = tb + q;
            if (tok < t_hi) {
#pragma unroll
                for (int ps = 0; ps < 2; ++ps) {
                    const int col = (4 * ps + (lane >> 4)) * 128 + v0;
                    const u32x4 af = a[q][ps], bf_ = bq[q][ps];
                    const f32x4 o0 = {bflo(af.x) + bflo(bf_.x), bfhi(af.x) + bfhi(bf_.x), bflo(af.y) + bflo(bf_.y), bfhi(af.y) + bfhi(bf_.y)};
                    const f32x4 o1 = {bflo(af.z) + bflo(bf_.z), bfhi(af.z) + bfhi(bf_.z), bflo(af.w) + bflo(bf_.w), bfhi(af.w) + bfhi(bf_.w)};
                    float ss = (o0[0] * o0[0] + o0[1] * o0[1]) + (o0[2] * o0[2] + o0[3] * o0[3]) + (o1[0] * o1[0] + o1[1] * o1[1]) + (o1[2] * o1[2] + o1[3] * o1[3]);
                    ss += shx(ss, 1, lane); ss += shx(ss, 2, lane); ss += shx(ss, 4, lane); ss += shx(ss, 8, lane);
                    const float rstd = rsqrtf(ss * (1.f / 128.f) + EPS);
                    const u32x4 g = gg[q][ps];
                    float r[8];
                    r[0] = o0[0] * rstd * gw0[0] * siluf_(bflo(g.x)); r[1] = o0[1] * rstd * gw0[1] * siluf_(bfhi(g.x));
                    r[2] = o0[2] * rstd * gw0[2] * siluf_(bflo(g.y)); r[3] = o0[3] * rstd * gw0[3] * siluf_(bfhi(g.y));
                    r[4] = o1[0] * rstd * gw1[0] * siluf_(bflo(g.z)); r[5] = o1[1] * rstd * gw1[1] * siluf_(bfhi(g.z));
                    r[6] = o1[2] * rstd * gw1[2] * siluf_(bflo(g.w)); r[7] = o1[3] * rstd * gw1[3] * siluf_(bfhi(g.w));
                    u32x4 o; o.x = pk2(r[0], r[1]); o.y = pk2(r[2], r[3]); o.z = pk2(r[4], r[5]); o.w = pk2(r[6], r[7]);
                    *(u32x4*)(MIX + (size_t)tok * D + col) = o;
                }
                float r[8];
#pragma unroll
                for (int e = 0; e < 4; ++e) {
                    r[2 * e] = bflo(cb[q][e]) * (bflo(cc[q][0][e]) * bflo(cx[q][0][e]) * cwt[0][2 * e] + bflo(cc[q][1][e]) * bflo(cx[q][1][e]) * cwt[1][2 * e] + bflo(cc[q][2][e]) * bflo(cx[q][2][e]) * cwt[2][2 * e]);
                    r[2 * e + 1] = bfhi(cb[q][e]) * (bfhi(cc[q][0][e]) * bfhi(cx[q][0][e]) * cwt[0][2 * e + 1] + bfhi(cc[q][1][e]) * bfhi(cx[q][1][e]) * cwt[1][2 * e + 1] + bfhi(cc[q][2][e]) * bfhi(cx[q][2][e]) * cwt[2][2 * e + 1]);
                }
                u32x4 o; o.x = pk2(r[0], r[1]); o.y = pk2(r[2], r[3]); o.z = pk2(r[4], r[5]); o.w = pk2(r[6], r[7]);
                *(u32x4*)(MIX + (size_t)tok * D + 1024 + c0) = o;
            }
        }
    }
}

template <int TG> DI void scan_consts(const LAS float* TOT, int lane, float E80, float (&Ceb)[2], float (&Cek)[2], float (&Aed)[2], float (&Aen)[2], float (&Gall)[2]) {
    float pre[2] = {1.f, 1.f}, post[2] = {1.f, 1.f}, mid[2] = {1.f, 1.f}, own[2] = {1.f, 1.f};
#pragma unroll
    for (int gq = 0; gq < 8; ++gq) {
        const f32x2 gt = *(const LAS f32x2*)(TOT + gq * 128 + 2 * lane);
        const bool inmid = TG >= 4 ? (gq >= 4 && gq < TG) : (gq > TG && gq <= 3);
#pragma unroll
        for (int ch = 0; ch < 2; ++ch) {
            const float gv = gt[ch];
            if (gq < TG) pre[ch] *= gv;
            if (gq > TG) post[ch] *= gv;
            if (inmid) mid[ch] *= gv;
            if (gq == TG) own[ch] = gv;
        }
    }
#pragma unroll
    for (int ch = 0; ch < 2; ++ch) {
        Ceb[ch] = pre[ch]; Cek[ch] = own[ch] * post[ch]; Gall[ch] = pre[ch] * own[ch] * post[ch];
        if (TG >= 4) { Aed[ch] = mid[ch]; Aen[ch] = fminf(__builtin_amdgcn_rcpf(mid[ch]), E80); }
        else { Aen[ch] = own[ch] * mid[ch]; Aed[ch] = fminf(__builtin_amdgcn_rcpf(Aen[ch]), E80); }
    }
}
constexpr int SC_QI = 0, SC_QP = 8448, SC_KP = SC_QP + 8704, SC_KHT = SC_KP + 8704, SC_VTS = SC_KHT + 10240, SC_EBL = SC_VTS + 10240, SC_TOT = SC_EBL + 512, SC_XCH = SC_TOT + 4096, SC_END = SC_XCH + 16384;
DI void scan_item(const Prm& p, LAS unsigned char* L, int l, int stream, int b, int h, int dir) {
    const int tid = opaque_tid(), lane = tid & 63;
    const int wave = __builtin_amdgcn_readfirstlane(tid >> 6), wq = wave & 3, kp = wave >> 2, tg = wave;
    const int N = stream ? 1024 : 256, row0 = stream ? TP + b * 1024 : b * 256;
    LAS unsigned char* QI = L + SC_QI; LAS unsigned char* QP = L + SC_QP; LAS unsigned char* KP = L + SC_KP; LAS unsigned char* KHT = L + SC_KHT; LAS unsigned char* VTS = L + SC_VTS;
    LAS float* EBL = (LAS float*)(L + SC_EBL); LAS float* TOT = (LAS float*)(L + SC_TOT); LAS float* XCH = (LAS float*)(L + SC_XCH);
    const bf16_t* P = (const bf16_t*)(p.ws + WS_P); const bf16_t* HIT = (const bf16_t*)(p.ws + WS_HIT);
    bf16_t* OO = (bf16_t*)(p.ws + (dir ? WS_OB : WS_OF));
    float lb[2] = {0.f, 0.f};
    if (l == 1) {
        const float* raw = p.in[11];
#pragma unroll
        for (int ch = 0; ch < 2; ++ch) { const int k = h * 128 + 2 * lane + ch; const float r0 = raw[(dir * 2 + 0) * 1024 + k], r1 = raw[(dir * 2 + 1) * 1024 + k]; lb[ch] = 1.f / (1.f + __expf(r0 - r1)); }
    }
    const int n31 = lane & 31, hh = lane >> 5, vcol = 32 * wq + n31;
    f32x16 S[4];
#pragma unroll
    for (int kt = 0; kt < 4; ++kt)
#pragma unroll
        for (int r = 0; r < 16; ++r) S[kt][r] = 0.f;
    if (stream) {
        const float* sp = p.in[4] + ((((size_t)b * 2 + l) * 2 + dir) * 8 + h) * 16384;
#pragma unroll
        for (int kt = 0; kt < 4; ++kt)
            if ((kt == 0) == (kp == 0)) {
#pragma unroll
                for (int r = 0; r < 16; ++r) S[kt][r] = sp[(32 * kt + crow(r, hh)) * 128 + vcol];
            }
    }
    const bf16_t* Pq = P + (size_t)row0 * NIN + C_HQ + h * 128 + 2 * lane;
    const bf16_t* Pf = P + (size_t)row0 * NIN + (dir ? C_HFB : C_HFF) + h * 128 + 2 * lane;
    const int vv = tid & 127, vp = tid >> 7;
    const bf16_t* Hv = HIT + (size_t)(h * 128 + vv) * T + row0;
    const int nchunk = N / 32, ostride = dir ? -1024 : 1024;
    unsigned xr[4], qr[4]; u32x4 va;
    auto load_chunk = [&](int c) {
#pragma unroll
        for (int t = 0; t < 4; ++t) {
            const int i = 32 * c + 4 * tg + t, tok = dir ? N - 1 - i : i;
            xr[t] = *(const unsigned*)(Pf + (size_t)tok * NIN); qr[t] = *(const unsigned*)(Pq + (size_t)tok * NIN);
        }
        va = *(const u32x4*)(dir ? Hv + N - 32 * c - 8 * vp - 8 : Hv + 32 * c + 8 * vp);
    };
    load_chunk(0);
    const float E80 = 5.5e34f;
    float c30 = 30.f; asm volatile("" : "+v"(c30));
    for (int c = 0; c < nchunk; ++c) {
        float lp[2][4], kk[2][4], qv[2][4];
#pragma unroll
        for (int t = 0; t < 4; ++t)
#pragma unroll
            for (int ch = 0; ch < 2; ++ch) {
                float x = ch ? bfhi(xr[t]) : bflo(xr[t]); qv[ch][t] = (ch ? bfhi(qr[t]) : bflo(qr[t])) * QSCALE;
                x = fminf(fmaxf(x, -c30), c30);
                const float e = __expf(-x), inv = __builtin_amdgcn_rcpf(1.f + e);
                lp[ch][t] = (1.f + lb[ch] * e) * inv;
                kk[ch][t] = (1.f - lb[ch]) * e * inv;
            }
#pragma unroll
        for (int ch = 0; ch < 2; ++ch) {
#pragma unroll
            for (int t = 1; t < 4; ++t) lp[ch][t] *= lp[ch][t - 1];
        }
        { f32x2 tt = {lp[0][3], lp[1][3]}; *(LAS f32x2*)(TOT + tg * 128 + 2 * lane) = tt; }
        {
            u32x4 w = va;
            if (dir) { w.x = (va.w >> 16) | (va.w << 16); w.y = (va.z >> 16) | (va.z << 16); w.z = (va.y >> 16) | (va.y << 16); w.w = (va.x >> 16) | (va.x << 16); }
            *(LAS u32x4*)(VTS + vv * 80 + 16 * vp) = w;
        }
        __syncthreads();
        float Ceb[2], Cek[2], Aed[2], Aen[2], Gall[2];
        switch (tg) {
            case 0: scan_consts<0>(TOT, lane, E80, Ceb, Cek, Aed, Aen, Gall); break;
            case 1: scan_consts<1>(TOT, lane, E80, Ceb, Cek, Aed, Aen, Gall); break;
            case 2: scan_consts<2>(TOT, lane, E80, Ceb, Cek, Aed, Aen, Gall); break;
            case 3: scan_consts<3>(TOT, lane, E80, Ceb, Cek, Aed, Aen, Gall); break;
            case 4: scan_consts<4>(TOT, lane, E80, Ceb, Cek, Aed, Aen, Gall); break;
            case 5: scan_consts<5>(TOT, lane, E80, Ceb, Cek, Aed, Aen, Gall); break;
            case 6: scan_consts<6>(TOT, lane, E80, Ceb, Cek, Aed, Aen, Gall); break;
            default: scan_consts<7>(TOT, lane, E80, Ceb, Cek, Aed, Aen, Gall); break;
        }
        float khv[2][4];
#pragma unroll
        for (int t = 0; t < 4; ++t) {
            const int ii = 4 * tg + t;
            float eb[2], ed[2], en[2];
#pragma unroll
            for (int ch = 0; ch < 2; ++ch) {
                const float l_ = lp[ch][t], rt = fminf(__builtin_amdgcn_rcpf(l_), E80);
                eb[ch] = l_ * Ceb[ch]; ed[ch] = l_ * Aed[ch]; en[ch] = fminf(rt * Aen[ch], E80);
                khv[ch][t] = kk[ch][t] * (rt * Cek[ch]);
            }
            *(LAS unsigned*)(QI + ii * 264 + 4 * lane) = pk2(qv[0][t] * eb[0], qv[1][t] * eb[1]);
            *(LAS unsigned*)(QP + ii * 272 + 4 * lane) = pk2(qv[0][t] * ed[0], qv[1][t] * ed[1]);
            *(LAS unsigned*)(KP + ii * 272 + 4 * lane) = pk2(kk[0][t] * en[0], kk[1][t] * en[1]);
        }
#pragma unroll
        for (int ch = 0; ch < 2; ++ch) { u32x2 w; w.x = pk2(khv[ch][0], khv[ch][1]); w.y = pk2(khv[ch][2], khv[ch][3]); *(LAS u32x2*)(KHT + (2 * lane + ch) * 80 + 8 * tg) = w; }
        if (tg == 0) { f32x2 e2 = {Gall[0], Gall[1]}; *(LAS f32x2*)(EBL + 2 * lane) = e2; }
        __syncthreads();
        if (c + 1 < nchunk) load_chunk(c + 1);
        f32x16 ao;
#pragma unroll
        for (int r = 0; r < 16; ++r) ao[r] = 0.f;
#pragma unroll
        for (int kt = 0; kt < 4; ++kt)
            if ((kt == 0) == (kp == 0)) {
#pragma unroll
                for (int s = 0; s < 2; ++s) {
                    const bf16x8 Bf = pack8(S[kt], s);
                    const int k0 = 32 * kt + 16 * s + 4 * hh;
                    const s16x4 lo = *(const LAS s16x4*)(QI + n31 * 264 + 2 * k0), hi = *(const LAS s16x4*)(QI + n31 * 264 + 2 * (k0 + 8));
                    ao = MFMA32(cat4(lo, hi), Bf, ao);
                }
            }
        if (kp == 0) {
            f32x16 X0, X1;
#pragma unroll
            for (int r = 0; r < 16; ++r) { X0[r] = 0.f; X1[r] = 0.f; }
#pragma unroll
            for (int ks = 0; ks < 8; ks += 2) {
                const bf16x8 A0 = *(const LAS bf16x8*)(KP + n31 * 272 + 2 * (16 * ks + 8 * hh)), B0 = *(const LAS bf16x8*)(QP + n31 * 272 + 2 * (16 * ks + 8 * hh));
                const bf16x8 A1 = *(const LAS bf16x8*)(KP + n31 * 272 + 2 * (16 * ks + 16 + 8 * hh)), B1 = *(const LAS bf16x8*)(QP + n31 * 272 + 2 * (16 * ks + 16 + 8 * hh));
                X0 = MFMA32(A0, B0, X0); X1 = MFMA32(A1, B1, X1);
            }
#pragma unroll
            for (int r = 0; r < 16; ++r) X0[r] = (crow(r, hh) <= n31) ? X0[r] + X1[r] : 0.f;
#pragma unroll
            for (int s = 0; s < 2; ++s) {
                const bf16x8 Af = pack8(X0, s);
                const int j0 = 16 * s + 4 * hh;
                const s16x4 lo = *(const LAS s16x4*)(VTS + vcol * 80 + 2 * j0), hi = *(const LAS s16x4*)(VTS + vcol * 80 + 2 * (j0 + 8));
                ao = MFMA32(Af, cat4(lo, hi), ao);
            }
        }
#pragma unroll
        for (int kt = 0; kt < 4; ++kt)
            if ((kt == 0) == (kp == 0)) {
#pragma unroll
                for (int g = 0; g < 4; ++g) {
                    const f32x4 e = *(const LAS f32x4*)(EBL + 32 * kt + 8 * g + 4 * hh);
#pragma unroll
                    for (int j = 0; j < 4; ++j) S[kt][4 * g + j] *= e[j];
                }
#pragma unroll
                for (int s = 0; s < 2; ++s) {
                    const bf16x8 Af = *(const LAS bf16x8*)(KHT + (32 * kt + n31) * 80 + 2 * (16 * s + 8 * hh));
                    const bf16x8 Bf = *(const LAS bf16x8*)(VTS + vcol * 80 + 2 * (16 * s + 8 * hh));
                    S[kt] = MFMA32(Af, Bf, S[kt]);
                }
            }
        if (kp == 1) {
#pragma unroll
            for (int g = 0; g < 4; ++g) { f32x4 v = {ao[4 * g], ao[4 * g + 1], ao[4 * g + 2], ao[4 * g + 3]}; *(LAS f32x4*)(XCH + wq * 1024 + g * 256 + lane * 4) = v; }
        }
        __syncthreads();
        if (kp == 0) {
            const int i0 = 32 * c + 4 * hh, tok0 = dir ? N - 1 - i0 : i0;
            bf16_t* ob = OO + (size_t)(row0 + tok0) * 1024 + h * 128 + vcol;
#pragma unroll
            for (int g = 0; g < 4; ++g) {
                const f32x4 v = *(const LAS f32x4*)(XCH + wq * 1024 + g * 256 + lane * 4);
#pragma unroll
                for (int j = 0; j < 4; ++j) ob[(j + 8 * g) * ostride] = f2bf(ao[4 * g + j] + v[j]);
            }
        }
    }
    if (!stream) {
        float* so = p.out + O_ST + ((((size_t)b * 2 + l) * 2 + dir) * 8 + h) * 16384;
#pragma unroll
        for (int kt = 0; kt < 4; ++kt)
            if ((kt == 0) == (kp == 0)) {
#pragma unroll
                for (int r = 0; r < 16; ++r) so[(32 * kt + crow(r, hh)) * 128 + vcol] = S[kt][r];
            }
    }
    __syncthreads();
}

constexpr int AT_KS = 0, AT_VS = 17408, AT_HALF = 35840, AT_RPB = 2 * AT_HALF, AT_END = AT_RPB + 4096;
constexpr float LOG2E = 1.4426950408889634f;
DI void attn_item(const Prm& p, LAS unsigned char* L, int l, int item) {
    const int tid = opaque_tid(), wave = tid >> 6, lane = tid & 63, kh = wave >> 2, qg = wave & 3, td = tid & 255;
    const int n16 = lane & 15, g = lane >> 4;
    float l2e_ = LOG2E; asm volatile("" : "+v"(l2e_));
    const bf16_t* P = (const bf16_t*)(p.ws + WS_P); const bf16_t* VT = (const bf16_t*)(p.ws + WS_VT);
    const bf16_t* KC = (const bf16_t*)(p.ws + WS_KC); const bf16_t* VCT = (const bf16_t*)(p.ws + WS_VCT);
    bf16_t* MIX = (bf16_t*)(p.ws + WS_MIX);
    const bool na = item >= 256;
    int b, h, qrow0, ntl, rq = 0, rs = 0;
    if (!na) { b = item >> 4; h = (item >> 2) & 3; qrow0 = b * 256 + (item & 3) * 64; ntl = 2; }
    else { const int it = item - 256; b = it >> 6; h = (it >> 4) & 3; rq = it & 15; qrow0 = TP + b * 1024 + rq * 64; ntl = 8; rs = min(max(rq - 4, 0), 8); }
    LAS unsigned char* KS = L + kh * AT_HALF + AT_KS; LAS unsigned char* VS = L + kh * AT_HALF + AT_VS;
    LAS float* RPB = (LAS float*)(L + AT_RPB) + 64;
    const bool band = na && kh == 0;
    unsigned vmask = 0xffffu; int dcb = 0, nt_lo = 0, nt_hi = 3;
    float mk[16];
#pragma unroll
    for (int i = 0; i < 16; ++i) mk[i] = 0.f;
    if (band) {
        const int qc = 16 * qg + n16, cs = min(max(qc - 8, 0), 48);
        vmask = 0u;
#pragma unroll
        for (int nt = 0; nt < 4; ++nt)
#pragma unroll
            for (int r = 0; r < 4; ++r) { const int kc = 16 * nt + 4 * g + r; const bool ok = kc >= cs && kc < cs + 16; if (ok) vmask |= 1u << (4 * nt + r); mk[4 * nt + r] = ok ? 0.f : -1e30f; }
        dcb = 4 * g - qc + 15;
        nt_lo = max(qg - 1, 0); nt_hi = min(qg + 1, 3);
    }
    bf16x8 Qf[4];
    { const bf16_t* qp = P + (size_t)(qrow0 + 16 * qg + n16) * NIN + C_NQ + h * 128 + 8 * g;
#pragma unroll
      for (int ks = 0; ks < 4; ++ks) Qf[ks] = *(const bf16x8*)(qp + 32 * ks); }
    f32x4 O[8];
#pragma unroll
    for (int dt = 0; dt < 8; ++dt) O[dt] = (f32x4){0.f, 0.f, 0.f, 0.f};
    float mrun = -1e30f, lsum = 0.f;
    u32x4 kr[4], vr[4];
    auto load_tile = [&](int t) {
        const bf16_t* ksrc; const bf16_t* vsrc; int ldk, ldv;
        if (!na) { const int kt = 2 * kh + t; ksrc = P + (size_t)(b * 256 + kt * 64) * NIN + C_NK + h * 128; ldk = NIN; vsrc = VT + (size_t)(h * 128) * T + b * 256 + kt * 64; ldv = T; }
        else if (kh == 0) { const int tr = TP + b * 1024 + (rs + t) * 64; ksrc = P + (size_t)tr * NIN + C_NK + h * 128; ldk = NIN; vsrc = VT + (size_t)(h * 128) * T + tr; ldv = T; }
        else { const size_t bh = (size_t)((b * 2 + l) * 4 + h); ksrc = KC + bh * 65536 + (size_t)t * 64 * 128; ldk = 128; vsrc = VCT + bh * 65536 + t * 64; ldv = 512; }
#pragma unroll
        for (int i = 0; i < 4; ++i) {
            const int id = td + 256 * i;
            kr[i] = *(const u32x4*)(ksrc + (size_t)(id >> 4) * ldk + (id & 15) * 8);
            vr[i] = *(const u32x4*)(vsrc + (size_t)(id >> 3) * ldv + (id & 7) * 8);
        }
    };
    load_tile(0);
    if (na) { const float* rp = p.in[14] + (size_t)(l * 4 + h) * 465; for (int i = tid; i < 465; i += 512) RPB[i] = rp[i]; if (tid < 64) { RPB[tid - 64] = 0.f; RPB[465 + tid] = 0.f; } }
    for (int t = 0; t < ntl; ++t) {
        __syncthreads();
#pragma unroll
        for (int i = 0; i < 4; ++i) {
            const int id = td + 256 * i;
            *(LAS u32x4*)(KS + (id >> 4) * 272 + (id & 15) * 16) = kr[i];
            *(LAS u32x4*)(VS + (id >> 3) * 144 + (id & 7) * 16) = vr[i];
        }
        __syncthreads();
        if (t + 1 < ntl) load_tile(t + 1);
        f32x4 Sx[4];
#pragma unroll
        for (int nt = 0; nt < 4; ++nt) {
            Sx[nt] = (f32x4){0.f, 0.f, 0.f, 0.f};
            if (nt >= nt_lo && nt <= nt_hi) {
#pragma unroll
                for (int ks = 0; ks < 4; ++ks) {
                    const bf16x8 Af = *(const LAS bf16x8*)(KS + (16 * nt + n16) * 272 + 2 * (32 * ks + 8 * g));
                    Sx[nt] = MFMA16(Af, Qf[ks], Sx[nt]);
                }
            }
        }
        if (band) {
            const LAS float* rb = RPB + (rs + t - rq + 7) * 31 + dcb;
#pragma unroll
            for (int nt = 0; nt < 4; ++nt)
#pragma unroll
                for (int r = 0; r < 4; ++r) Sx[nt][r] = (Sx[nt][r] * QSCALE + rb[16 * nt + r]) + mk[4 * nt + r];
        } else {
#pragma unroll
            for (int nt = 0; nt < 4; ++nt) Sx[nt] = Sx[nt] * QSCALE;
        }
        float mx = -1e30f;
#pragma unroll
        for (int nt = 0; nt < 4; ++nt) mx = fmaxf(mx, fmaxf(fmaxf(Sx[nt][0], Sx[nt][1]), fmaxf(Sx[nt][2], Sx[nt][3])));
        if (__builtin_amdgcn_ballot_w64(mx > mrun + 8.f) != 0ull) {
            mx = fmaxf(mx, shx(mx, 16, lane)); mx = fmaxf(mx, shx(mx, 32, lane));
            const float mn = fmaxf(mrun, mx), alpha = __builtin_amdgcn_exp2f((mrun - mn) * l2e_);
            mrun = mn; lsum *= alpha;
#pragma unroll
            for (int dt = 0; dt < 8; ++dt) O[dt] = O[dt] * alpha;
        }
        const float mL = mrun * l2e_;
        unsigned pp[8];
#pragma unroll
        for (int nt = 0; nt < 4; ++nt) {
            float pv[4];
#pragma unroll
            for (int r = 0; r < 4; ++r) { pv[r] = __builtin_amdgcn_exp2f(Sx[nt][r] * l2e_ - mL); lsum += pv[r]; }
            pp[2 * nt] = pk2(pv[0], pv[1]); pp[2 * nt + 1] = pk2(pv[2], pv[3]);
        }
#pragma unroll
        for (int kk = 0; kk < 2; ++kk) {
            if (2 * kk + 1 >= nt_lo && 2 * kk <= nt_hi) {
                const u32x4 pb = {pp[4 * kk], pp[4 * kk + 1], pp[4 * kk + 2], pp[4 * kk + 3]};
                const bf16x8 Bf = __builtin_bit_cast(bf16x8, pb);
#pragma unroll
                for (int dt = 0; dt < 8; ++dt) {
                    const LAS unsigned char* vp = VS + (16 * dt + n16) * 144 + 2 * (32 * kk + 4 * g);
                    const s16x4 lo = *(const LAS s16x4*)vp, hi = *(const LAS s16x4*)(vp + 32);
                    O[dt] = MFMA16(cat4(lo, hi), Bf, O[dt]);
                }
            }
        }
    }
    lsum += shx(lsum, 16, lane); lsum += shx(lsum, 32, lane);
    __syncthreads();
    LAS float* MO = (LAS float*)L; LAS float* MM = (LAS float*)(L + 34048); LAS float* ML = MM + 64;
    const int q = 16 * qg + n16;
    if (kh == 1) {
#pragma unroll
        for (int dt = 0; dt < 8; ++dt) *(LAS f32x4*)(MO + q * 132 + 16 * dt + 4 * g) = O[dt];
        if (g == 0) { MM[q] = mrun; ML[q] = lsum; }
    }
    __syncthreads();
    if (kh == 0) {
        const float m1 = MM[q], l1 = ML[q], mn = fmaxf(mrun, m1), a0 = __builtin_amdgcn_exp2f((mrun - mn) * l2e_), a1 = __builtin_amdgcn_exp2f((m1 - mn) * l2e_);
        const float inv = 1.f / (lsum * a0 + l1 * a1);
        bf16_t* op = MIX + (size_t)(qrow0 + q) * D + 1536 + h * 128 + 4 * g;
#pragma unroll
        for (int dt = 0; dt < 8; ++dt) {
            const f32x4 o1 = *(const LAS f32x4*)(MO + q * 132 + 16 * dt + 4 * g);
            const f32x4 o = (O[dt] * a0 + o1 * a1) * inv;
            u32x2 w; w.x = pk2(o[0], o[1]); w.y = pk2(o[2], o[3]);
            *(u32x2*)(op + 16 * dt) = w;
        }
    }
    __syncthreads();
}

DI void mixer_phase(const Prm& p, LAS unsigned char* L, int l) {
    const int G = gridDim.x;
    unsigned* ctr = (unsigned*)(p.ws + WS_FLG) + l;
    LAS int* slot = (LAS int*)(L + LDS_BYTES - 16);
    int item = blockIdx.x;
    while (item < 1152) {
        int nxt_item = 0;
        if (threadIdx.x == 0) nxt_item = G + (int)__hip_atomic_fetch_add(ctr, 1u, __ATOMIC_RELAXED, __HIP_MEMORY_SCOPE_AGENT);
        if (item < 128) scan_item(p, L, l, 1, item >> 4, (item >> 1) & 7, item & 1);
        else if (item < 640) attn_item(p, L, l, 256 + (item - 128));
        else if (item < 896) { const int ix = item - 640; scan_item(p, L, l, 0, ix >> 4, (ix >> 1) & 7, ix & 1); }
        else attn_item(p, L, l, item - 896);
        if (threadIdx.x == 0) *slot = nxt_item;
        __syncthreads();
        item = *slot;
        __syncthreads();
    }
}

#ifndef PH_MASK
#define PH_MASK 0x3ff
#endif
#define PHASE_ON(bit) ((PH_MASK >> (bit)) & 1)
__global__ void __launch_bounds__(512, 2) mega_fwd(Prm p) {
    extern __shared__ __attribute__((aligned(16))) unsigned char lds_raw[];
    LAS unsigned char* L = (LAS unsigned char*)lds_raw;
    cg::grid_group grid = cg::this_grid();
    const int lo = p.ph_lo, hi = p.ph_hi;
    if (lo < 0) grid.sync();
    volatile LAS unsigned* xst = (volatile LAS unsigned*)(L + 131072);
    if (threadIdx.x < 2) xst[threadIdx.x] = 0u;
    __syncthreads();
    const XcdBarrier xb = xcd_barrier_post((unsigned*)(p.ws + WS_BAR), xst);
#define PH_BEGIN(n) if (lo <= (n) && (n) < hi) {
#define PH_END(n) if ((n) + 1 < hi) xcd_barrier(xb); }
    PH_BEGIN(0) if (PHASE_ON(0)) prologue_phase(p, L); PH_END(0)
#pragma nounroll
    for (int l = 0; l < 2; ++l) {
        const int pb = 1 + 8 * l;
        bf16_t* H = (bf16_t*)(p.ws + WS_H); bf16_t* MIX = (bf16_t*)(p.ws + WS_MIX); bf16_t* P = (bf16_t*)(p.ws + WS_P); float* X = (float*)(p.ws + WS_X);
        const float* MODl = (const float*)(p.ws + WS_MOD) + (size_t)l * 9 * 12288;
        PH_BEGIN(pb + 0) if (PHASE_ON(2)) norm_phase(p, l, 0, l == 0); PH_END(pb + 0)
        PH_BEGIN(pb + 1) if (PHASE_ON(3)) {
            pg8::StaticOrder S; pg8::Gemm g{H, (const bf16_t*)(p.ws + WS_WIN) + (size_t)l * NIN * D, T, NIN, D};
            EpiInProj E{P, (bf16_t*)(p.ws + WS_VT), (bf16_t*)(p.ws + WS_HIT), p.out + O_NK, p.out + O_NV, l};
            S.init(T, NIN, gridDim.x, blockIdx.x); pg8::gemm_phase<EpiInProj, pg8::StaticOrder>(L, g, S, E);
        } PH_END(pb + 1)
        PH_BEGIN(pb + 2) if (PHASE_ON(4)) mixer_phase(p, L, l); PH_END(pb + 2)
        PH_BEGIN(pb + 3) if (PHASE_ON(5)) combine_phase(p, l); PH_END(pb + 3)
        PH_BEGIN(pb + 4) if (PHASE_ON(6)) {
            pg8::HalfOrder<1> S; pg8::Gemm g{MIX, (const bf16_t*)(p.ws + WS_WOUT) + (size_t)l * D * D, T, D, D};
            EpiResid E{X, MODl + 4096, l == 0 ? p.in[0] : nullptr, l == 0 ? p.in[1] : nullptr};
            S.init(T, D, gridDim.x, blockIdx.x); pg8::gemm_phase<EpiResid, pg8::HalfOrder<1>>(L, g, S, E);
        } PH_END(pb + 4)
        PH_BEGIN(pb + 5) if (PHASE_ON(7)) norm_phase(p, l, 1, false); PH_END(pb + 5)
        PH_BEGIN(pb + 6) if (PHASE_ON(8)) {
            pg8::HalfOrder<2> S; pg8::Gemm g{H, (const bf16_t*)(p.ws + WS_WGU) + (size_t)l * NGU * D, T, NGU, D};
            EpiSwiGLU E{P};
            S.init(T, NGU, gridDim.x, blockIdx.x); pg8::gemm_phase<EpiSwiGLU, pg8::HalfOrder<2>>(L, g, S, E);
        } PH_END(pb + 6)
        PH_BEGIN(pb + 7) if (PHASE_ON(9)) {
            pg8::HalfOrder<1> S; pg8::Gemm g{P, (const bf16_t*)(p.ws + WS_WD) + (size_t)l * D * FF, T, D, FF};
            EpiResid E{X, MODl + 10240, nullptr, nullptr};
            S.init(T, D, gridDim.x, blockIdx.x); pg8::gemm_phase<EpiResid, pg8::HalfOrder<1>>(L, g, S, E);
        } PH_END(pb + 7)
    }
    PH_BEGIN(17) if (PHASE_ON(1)) norm_phase(p, 0, 2, false); PH_END(17)
}

extern "C" void kernel_launch(void* const* d_in, const int* in_sizes, int n_in, void* d_out, int out_size, void* d_ws, size_t ws_size, hipStream_t stream) {
    static int grid = 0;
    if (grid == 0) {
        if (n_in != 21 || ws_size < WS_END) { fprintf(stderr, "kernel_launch: need 21 inputs and %zu B of workspace; got %d, %zu\n", (size_t)WS_END, n_in, ws_size); grid = -1; return; }
        int dev = 0, cus = 0, per_cu = 0;
        hipGetDevice(&dev); hipDeviceGetAttribute(&cus, hipDeviceAttributeMultiprocessorCount, dev);
        if (hipFuncSetAttribute((const void*)mega_fwd, hipFuncAttributeMaxDynamicSharedMemorySize, LDS_BYTES) != hipSuccess) { fprintf(stderr, "kernel_launch: hipFuncSetAttribute failed\n"); grid = -1; return; }
        hipOccupancyMaxActiveBlocksPerMultiprocessor(&per_cu, (const void*)mega_fwd, 512, LDS_BYTES);
        (void)hipGetLastError();
        if (per_cu < 1) per_cu = 1;
        grid = cus * per_cu;
    }
    if (grid < 0) return;
    if (hipMemsetAsync((char*)d_ws + WS_FLG, 0, 4096 + 16384, stream) != hipSuccess) { fprintf(stderr, "kernel_launch: memset of control words failed\n"); return; }
    Prm p{};
    for (int i = 0; i < 21; ++i) p.in[i] = (const float*)d_in[i];
    p.out = (float*)d_out; p.ws = (unsigned char*)d_ws; p.ph_lo = 0; p.ph_hi = 18;
    void* args[] = {&p};
    hipError_t e = hipLaunchCooperativeKernel((const void*)mega_fwd, dim3(grid), dim3(512), args, LDS_BYTES, stream);
    if (e != hipSuccess) fprintf(stderr, "cooperative launch failed: %s (grid %d)\n", hipGetErrorString(e), grid);
}
```

```cpp
#include <hip/hip_runtime.h>
#include <hip/hip_cooperative_groups.h>
#include <cstdio>
#include <cstdint>
namespace cg = cooperative_groups;

#define DI __device__ __forceinline__
#define LAS __attribute__((address_space(3)))
typedef unsigned short bf16_t;
typedef short bf16x8 __attribute__((ext_vector_type(8)));
typedef short s16x4 __attribute__((ext_vector_type(4)));
typedef float f32x2 __attribute__((ext_vector_type(2)));
typedef float f32x4 __attribute__((ext_vector_type(4)));
typedef float f32x16 __attribute__((ext_vector_type(16)));
typedef unsigned u32x2 __attribute__((ext_vector_type(2)));
typedef unsigned u32x4 __attribute__((ext_vector_type(4)));
typedef __bf16 bfv2 __attribute__((ext_vector_type(2)));

constexpr int T = 12288, TP = 4096, D = 2048, NIN = 8192, FF = 5632, NGU = 11264;
constexpr float EPS = 1e-6f;
constexpr float QSCALE = 0.08838834764831845f;
constexpr int C_HQ = 0, C_HI = 1024, C_HFF = 2048, C_HFB = 3072, C_HG = 4096, C_CB = 5120, C_CC = 5632, C_CX = 6144, C_NQ = 6656, C_NK = 7168, C_NV = 7680;
constexpr size_t O_Y = 0, O_NK = (size_t)T * D, O_NV = O_NK + 4194304, O_ST = O_NV + 4194304;
constexpr size_t WS_X = 0;
constexpr size_t WS_H = WS_X + (size_t)T * D * 4;
constexpr size_t WS_MIX = WS_H + (size_t)T * D * 2;
constexpr size_t WS_P = WS_MIX + (size_t)T * D * 2;
constexpr size_t WS_OF = WS_P + (size_t)T * NIN * 2;
constexpr size_t WS_OB = WS_OF + (size_t)T * 1024 * 4;
constexpr size_t WS_VT = WS_OB + (size_t)T * 1024 * 4;
constexpr size_t WS_HIT = WS_VT + (size_t)512 * T * 2;
constexpr size_t WS_KC = WS_HIT + (size_t)1024 * T * 2;
constexpr size_t WS_VCT = WS_KC + (size_t)8 * 2 * 4 * 512 * 128 * 2;
constexpr size_t WS_WIN = WS_VCT + (size_t)8 * 2 * 4 * 512 * 128 * 2;
constexpr size_t WS_WOUT = WS_WIN + (size_t)2 * NIN * D * 2;
constexpr size_t WS_WGU = WS_WOUT + (size_t)2 * D * D * 2;
constexpr size_t WS_WD = WS_WGU + (size_t)2 * NGU * D * 2;
constexpr size_t WS_MOD = WS_WD + (size_t)2 * D * FF * 2;
constexpr size_t WS_FLG = WS_MOD + (size_t)2 * 9 * 12288 * 4;
constexpr size_t WS_BAR = WS_FLG + 4096;
constexpr size_t WS_END = WS_BAR + 16384;
constexpr int LDS_BYTES = 131072 + 64;

struct Prm { const float* in[21]; float* out; unsigned char* ws; int ph_lo, ph_hi; };

DI unsigned pk2(float lo, float hi) { f32x2 v = {lo, hi}; return __builtin_bit_cast(unsigned, __builtin_convertvector(v, bfv2)); }
DI bf16_t f2bf(float f) { return __builtin_bit_cast(unsigned short, (__bf16)f); }
DI float bf2f(bf16_t b) { return __uint_as_float(((unsigned)b) << 16); }
DI float bflo(unsigned w) { return __uint_as_float(w << 16); }
DI float bfhi(unsigned w) { return __uint_as_float(w & 0xffff0000u); }
DI float shx(float v, int o, int lane) { return __int_as_float(__builtin_amdgcn_ds_bpermute((lane ^ o) << 2, __float_as_int(v))); }
DI float wave_sum(float v, int lane) {
#pragma unroll
    for (int o = 1; o < 64; o <<= 1) v += shx(v, o, lane);
    return v;
}
DI void lds_wait() { asm volatile("s_waitcnt lgkmcnt(0)" ::: "memory"); }
DI float sigmoidf_(float x) { return __builtin_amdgcn_rcpf(1.f + __expf(-x)); }
DI float siluf_(float x) { return x * __builtin_amdgcn_rcpf(1.f + __expf(-x)); }
#define MFMA32(a, b, c) __builtin_amdgcn_mfma_f32_32x32x16_bf16((a), (b), (c), 0, 0, 0)
#define MFMA16(a, b, c) __builtin_amdgcn_mfma_f32_16x16x32_bf16((a), (b), (c), 0, 0, 0)
DI int crow(int reg, int h) { return (reg & 3) + 8 * (reg >> 2) + 4 * h; }
DI bf16x8 pack8(const f32x16& x, int s) {
    u32x4 p; p.x = pk2(x[8 * s], x[8 * s + 1]); p.y = pk2(x[8 * s + 2], x[8 * s + 3]); p.z = pk2(x[8 * s + 4], x[8 * s + 5]); p.w = pk2(x[8 * s + 6], x[8 * s + 7]);
    return __builtin_bit_cast(bf16x8, p);
}
DI bf16x8 cat4(s16x4 lo, s16x4 hi) { return __builtin_shufflevector(lo, hi, 0, 1, 2, 3, 4, 5, 6, 7); }

DI int opaque_tid() { int t = threadIdx.x; asm volatile("" : "+v"(t)); return t; }

#define XB_TMO      128
#define XB_XCNT(j)  (256  + 64 * (j))
#define XB_XSUB(j)  (1280 + 64 * (j))
#define XB_XGEN(j)  (2304 + 64 * (j))
#define XB_TOP      3328
#define XB_TOPGEN   3392
#define XCD_BAR_WORDS 3456
#define XB_SPIN_CAP (1u << 18)

__device__ __forceinline__ unsigned xb_ld(unsigned* p)              { return __hip_atomic_load(p, __ATOMIC_RELAXED, __HIP_MEMORY_SCOPE_AGENT); }
__device__ __forceinline__ unsigned xb_add(unsigned* p, unsigned v) { return __hip_atomic_fetch_add(p, v, __ATOMIC_RELAXED, __HIP_MEMORY_SCOPE_AGENT); }
__device__ __forceinline__ unsigned xb_xcc_id() { return (unsigned)__builtin_amdgcn_s_getreg((3 << 11) | 20) & 0xFu; }
#define XB_SPIN(cond, bar) do { unsigned _sp = 0; while (cond) { __builtin_amdgcn_s_sleep(1); \
    if ((++_sp & 255u) == 0u) { if (xb_ld(&(bar)[XB_TMO])) break; if (_sp > XB_SPIN_CAP) { atomicAdd(&(bar)[XB_TMO], 1u); break; } } } } while (0)

struct XcdBarrier {
    unsigned* bar; unsigned x;
    volatile LAS unsigned* st;
};

__device__ __forceinline__ XcdBarrier xcd_barrier_post(unsigned* bar, volatile LAS unsigned* st) {
    XcdBarrier b; b.bar = bar; b.x = xb_xcc_id(); b.st = st;
    if (threadIdx.x == 0) (void)xb_add(&bar[XB_XCNT(b.x)], 1u);
    return b;
}
__device__ __forceinline__ void xcd_barrier_complete(unsigned* bar, unsigned x, unsigned& nloc, unsigned& nx) {
    const unsigned G = gridDim.x * gridDim.y * gridDim.z;
    unsigned sum, cnt, mine, sp = 0u;
    for (;;) {
        sum = 0u; cnt = 0u; mine = 0u;
        unsigned cv[16];
#pragma unroll
        for (unsigned j = 0; j < 16; ++j) cv[j] = xb_ld(&bar[XB_XCNT(j)]);
#pragma unroll
        for (unsigned j = 0; j < 16; ++j) { const unsigned c = cv[j]; sum += c; cnt += (c > 0u) ? 1u : 0u; mine = (j == x) ? c : mine; }
        if (sum == G) break;
        __builtin_amdgcn_s_sleep(1);
        if ((++sp & 255u) == 0u) { if (xb_ld(&bar[XB_TMO])) break; if (sp > XB_SPIN_CAP) { atomicAdd(&bar[XB_TMO], 1u); break; } }
    }
    nloc = mine > 0u ? mine : 1u; nx = cnt > 0u ? cnt : 1u;
}

__device__ __forceinline__ void xcd_barrier(const XcdBarrier& b) {
    asm volatile("s_waitcnt vmcnt(0)" ::: "memory");
    __syncthreads();
    if (threadIdx.x == 0) {
        unsigned* bar = b.bar;
        __builtin_amdgcn_s_waitcnt(0);
        unsigned nloc = b.st[0], nx = b.st[1];
        if (nloc == 0u) { xcd_barrier_complete(bar, b.x, nloc, nx); b.st[0] = nloc; b.st[1] = nx; }
        const unsigned old = xb_add(&bar[XB_XSUB(b.x)], 1u);
        const unsigned gen = old / nloc;
        if (old + 1u == (gen + 1u) * nloc) {
            __builtin_amdgcn_fence(__ATOMIC_RELEASE, "agent");
            asm volatile("s_waitcnt vmcnt(0)" ::: "memory");
            const unsigned og = xb_add(&bar[XB_TOP], 1u);
            const unsigned tg = og / nx;
            if (og + 1u == (tg + 1u) * nx) xb_add(&bar[XB_TOPGEN], 1u);
            else XB_SPIN(xb_ld(&bar[XB_TOPGEN]) == tg, bar);
            __builtin_amdgcn_fence(__ATOMIC_ACQUIRE, "agent");
            xb_add(&bar[XB_XGEN(b.x)], 1u);
            asm volatile("s_waitcnt vmcnt(0)" ::: "memory");
        } else {
            XB_SPIN(xb_ld(&bar[XB_XGEN(b.x)]) == gen, bar);
            __builtin_amdgcn_fence(__ATOMIC_ACQUIRE, "agent");
            asm volatile("s_waitcnt vmcnt(0)" ::: "memory");
        }
    }
    __syncthreads();
}

namespace pg8 {
#define PG8_LAS __attribute__((address_space(3)))
constexpr int BM = 256, BK = 64, HALF = 128, HTB = HALF * BK * 2  , STAGE_BYTES = 8 * HTB, NXCD = 8, WGM = 4;

__host__ __device__ __forceinline__ int lds_byte(int r, int c) { const int st = (r >> 4) * 2 + (c >> 5), rr = r & 15, cc = c & 31, ob = rr * 64 + cc * 2; return st * 1024 + (ob ^ (((ob >> 9) & 1) << 5)); }
__host__ __device__ __forceinline__ void stage_rc(int b, int& R, int& C) { const int st = b / 1024, sb = b % 1024, swz = sb ^ (((sb >> 9) & 1) << 5); R = (st >> 1) * 16 + swz / 64; C = (st & 1) * 32 + (swz % 64) / 2; }
__host__ __device__ __forceinline__ int perm32(int rho) { const int n = rho >> 4, i = rho & 15; return 8 * (i >> 2) + 4 * n + (i & 3); }

struct Unit { int pm, pn, sp, kh; };
struct Gemm { const bf16_t* A; const bf16_t* Bt; int M, N, K; };

struct StaticOrder {
    int nM, nN, nwg, G, c;
    __host__ __device__ void init(int M, int N, int G_, int c_) { nM = M / BM; nN = N / BM; nwg = nM * nN; G = G_; c = c_; }
    __host__ __device__ void map(long L, Unit& u) const {
        int wgid = (int)L; { const int q = nwg / NXCD, r = nwg % NXCD, xcd = wgid % NXCD, off = wgid / NXCD; wgid = (xcd < r ? xcd * (q + 1) : r * (q + 1) + (xcd - r) * q) + off; }
        const int nig = WGM * nN, gid = wgid / nig, fm = gid * WGM, gsz = (nM - fm) < WGM ? (nM - fm) : WGM;
        u.pm = fm + ((wgid % nig) % gsz); u.pn = (wgid % nig) / gsz;
    }
    __host__ __device__ bool next(int i, Unit& u) const {
        const long L = (long)i * G + c; if (L >= nwg) return false;
        u.sp = 0; u.kh = 0; map(L, u); return true;
    }
    __device__ __forceinline__ void a_ready(const Unit&) const {}
    __device__ __forceinline__ void done(const Unit&) const {}
};

template <int KIND> struct HalfOrder : StaticOrder {
    __host__ __device__ bool next(int i, Unit& u) const {
        const int frnd = nwg / G, rem = nwg - frnd * G;
        u.sp = 0; u.kh = 0;
        if (i < frnd) { map((long)i * G + c, u); return true; }
        if (i > frnd || rem == 0) return false;
        if (2 * rem <= G) { if (c >= 2 * rem) return false; u.sp = KIND; u.kh = c >= rem; map((long)frnd * G + (c >= rem ? c - rem : c), u); return true; }
        if (c >= rem) return false;
        map((long)frnd * G + c, u); return true;
    }
};

template <class Epi, class Sched>
__device__ __forceinline__ void gemm_phase(PG8_LAS unsigned char* lds, const Gemm g, const Sched& S, const Epi& E) {
    int tid_ = threadIdx.x; asm volatile("" : "+v"(tid_)); const int tid = tid_, wid = __builtin_amdgcn_readfirstlane(tid >> 6), lane = tid & 63, wr = wid >> 2, wc = wid & 3, fr = lane & 15, fq = lane >> 4;
    const int K = g.K, nt = K / BK;
    unsigned voffA[2], voffB[2];
#pragma unroll
    for (int i = 0; i < 2; ++i) { int R, C; stage_rc(tid * 16 + i * 8192, R, C); const int Rb = Epi::PERM ? ((R & ~31) + perm32(R & 31)) : R;
        voffA[i] = (unsigned)(R * K + C) * 2u; voffB[i] = (unsigned)(Rb * K + C) * 2u; }
    const size_t kstep = (size_t)(BK * 2);
    const size_t hstep = (size_t)HALF * K * 2;
    const size_t tstep = 2 * hstep;
    const unsigned ldsw = (unsigned)wid * 1024u;
    const int aoff = lds_byte(wr * 64 + fr, fq * 8), boff = lds_byte(wc * 32 + fr, fq * 8);
#define PG8_SA(b, h) (((b) * 2 + (h)) * HTB)
#define PG8_SB(b, h) ((4 + (b) * 2 + (h)) * HTB)
#define PG8_STAGE(bufoff, gbase, voff) do { _Pragma("unroll") for (int _i = 0; _i < 2; ++_i) \
        __builtin_amdgcn_global_load_lds((const unsigned*)((const char*)(gbase) + (voff)[_i]), (PG8_LAS unsigned*)(lds + (bufoff) + ldsw + _i * 8192), 16, 0, 0); } while (0)
#define PG8_LDA(dst, b, h) do { _Pragma("unroll") for (int m = 0; m < 4; ++m) _Pragma("unroll") for (int k = 0; k < 2; ++k) dst[m][k] = *(const PG8_LAS bf16x8*)(lds + PG8_SA(b, h) + aoff + m * 2048 + k * 1024); } while (0)
#define PG8_LDB(dst, b, h) do { _Pragma("unroll") for (int n = 0; n < 2; ++n) _Pragma("unroll") for (int k = 0; k < 2; ++k) dst[n][k] = *(const PG8_LAS bf16x8*)(lds + PG8_SB(b, h) + boff + n * 2048 + k * 1024); } while (0)
#define PG8_MMA(ai, bj, At, Bt) do { __builtin_amdgcn_s_setprio(1); _Pragma("unroll") for (int m = 0; m < 4; ++m) _Pragma("unroll") for (int n = 0; n < 2; ++n) _Pragma("unroll") for (int k = 0; k < 2; ++k) \
        acc[ai][bj][m][n] = __builtin_amdgcn_mfma_f32_16x16x32_bf16(Bt[n][k], At[m][k], acc[ai][bj][m][n], 0, 0, 0); __builtin_amdgcn_s_setprio(0); } while (0)
#define PG8_WAIT_V(n) asm volatile("s_waitcnt vmcnt(" #n ")" ::: "memory")
#define PG8_WAIT_L(n) asm volatile("s_waitcnt lgkmcnt(" #n ")" ::: "memory")
#define PG8_BAR __builtin_amdgcn_s_barrier()
#define PG8_SCHED __builtin_amdgcn_sched_barrier(0)
    Unit cur, nxt; int ui = 0;
    if (!S.next(0, cur)) return;
    f32x4 acc[2][2][4][2];
#pragma unroll
    for (int a = 0; a < 2; ++a)
#pragma unroll
        for (int b = 0; b < 2; ++b)
#pragma unroll
            for (int m = 0; m < 4; ++m)
#pragma unroll
                for (int n = 0; n < 2; ++n) acc[a][b][m][n] = (f32x4){0.f, 0.f, 0.f, 0.f};
    bf16x8 At[4][2], B0[2][2], B1[2][2];
    const char* cA = (const char*)g.A + (size_t)cur.pm * tstep + (cur.sp == 2 ? (size_t)cur.kh * hstep : 0); const char* cB = (const char*)g.Bt + (size_t)cur.pn * tstep + (cur.sp == 1 ? (size_t)cur.kh * hstep : 0);
    bool full = cur.sp != 1, fullm = cur.sp != 2;
    S.a_ready(cur);
    PG8_STAGE(PG8_SB(0, 0), cB, voffB); PG8_STAGE(PG8_SA(0, 0), cA, voffA); PG8_STAGE(PG8_SB(0, 1), cB + hstep, voffB); PG8_STAGE(PG8_SA(0, 1), cA + hstep, voffA);
    if (wr == 1) PG8_BAR;
    PG8_WAIT_V(4); PG8_BAR;
    PG8_STAGE(PG8_SB(1, 0), cB + kstep, voffB); PG8_STAGE(PG8_SA(1, 0), cA + kstep, voffA); PG8_STAGE(PG8_SB(1, 1), cB + hstep + kstep, voffB);
    PG8_WAIT_V(6); PG8_BAR;
    for (;;) {
        const bool has_next = S.next(ui + 1, nxt);
        const char* nA = has_next ? (const char*)g.A + (size_t)nxt.pm * tstep + (nxt.sp == 2 ? (size_t)nxt.kh * hstep : 0) : cA; const char* nB = has_next ? (const char*)g.Bt + (size_t)nxt.pn * tstep + (nxt.sp == 1 ? (size_t)nxt.kh * hstep : 0) : cB;
        for (int t = 0; t < nt; t += 2) {
            const bool last = (t == nt - 2);
            const char* a1 = cA + (size_t)(t + 1) * kstep;
            const char* a2 = last ? nA : cA + (size_t)(t + 2) * kstep; const char* b2 = last ? nB : cB + (size_t)(t + 2) * kstep;
            const char* a3 = a2 + kstep; const char* b3 = b2 + kstep;
            if (last && has_next) S.a_ready(nxt);
            PG8_LDB(B0, 0, 0); PG8_SCHED; PG8_LDA(At, 0, 0); PG8_STAGE(PG8_SA(1, 1), a1 + hstep, voffA);
            PG8_WAIT_L(8); PG8_BAR; PG8_WAIT_L(0); PG8_MMA(0, 0, At, B0); PG8_BAR; PG8_SCHED;
            if (full) PG8_LDB(B1, 0, 1); PG8_STAGE(PG8_SB(0, 0), b2, voffB);
            PG8_BAR; PG8_WAIT_L(0); if (full) PG8_MMA(0, 1, At, B1); PG8_BAR;
            if (fullm) PG8_LDA(At, 0, 1); PG8_STAGE(PG8_SA(0, 0), a2, voffA);
            PG8_BAR; PG8_WAIT_L(0); if (fullm) PG8_MMA(1, 0, At, B0); PG8_BAR; PG8_SCHED;
            PG8_STAGE(PG8_SB(0, 1), b2 + hstep, voffB);
            PG8_WAIT_V(6); PG8_BAR; if (full && fullm) PG8_MMA(1, 1, At, B1); PG8_BAR;
            PG8_LDB(B0, 1, 0); PG8_SCHED; PG8_LDA(At, 1, 0); PG8_STAGE(PG8_SA(0, 1), a2 + hstep, voffA);
            PG8_WAIT_L(8); PG8_BAR; PG8_WAIT_L(0); PG8_MMA(0, 0, At, B0); PG8_BAR; PG8_SCHED;
            if (full) PG8_LDB(B1, 1, 1); PG8_STAGE(PG8_SB(1, 0), b3, voffB);
            PG8_BAR; PG8_WAIT_L(0); if (full) PG8_MMA(0, 1, At, B1); PG8_BAR;
            if (fullm) PG8_LDA(At, 1, 1); PG8_STAGE(PG8_SA(1, 0), a3, voffA);
            PG8_BAR; PG8_WAIT_L(0); if (fullm) PG8_MMA(1, 0, At, B0); PG8_BAR; PG8_SCHED;
            PG8_STAGE(PG8_SB(1, 1), b3 + hstep, voffB);
            PG8_WAIT_V(6); PG8_BAR; if (full && fullm) PG8_MMA(1, 1, At, B1); PG8_BAR;
        }
        if constexpr (!Epi::AFTER_DRAIN) { E(acc, cur, wr, wc, fr, fq); S.done(cur); }
        if (!has_next) break;
#pragma unroll
        for (int a = 0; a < 2; ++a)
#pragma unroll
            for (int b = 0; b < 2; ++b)
#pragma unroll
                for (int m = 0; m < 4; ++m)
#pragma unroll
                    for (int n = 0; n < 2; ++n) acc[a][b][m][n] = (f32x4){0.f, 0.f, 0.f, 0.f};
        cur = nxt; cA = nA; cB = nB; ++ui; full = cur.sp != 1; fullm = cur.sp != 2;
    }
    PG8_WAIT_V(0);
    if (wr == 0) PG8_BAR;
    PG8_BAR;
    if constexpr (Epi::AFTER_DRAIN) { E.fused(acc, cur, wr, wc, fr, fq, lds, wid, lane); S.done(cur); }
#undef PG8_SA
#undef PG8_SB
#undef PG8_STAGE
#undef PG8_LDA
#undef PG8_LDB
#undef PG8_MMA
#undef PG8_WAIT_V
#undef PG8_WAIT_L
#undef PG8_BAR
#undef PG8_SCHED
}
}


struct EpiInProj {
    static constexpr bool PERM = true, AFTER_DRAIN = false;
    bf16_t* P; bf16_t* VT; bf16_t* HIT; float* out_k; float* out_v; int layer;
    DI void operator()(const f32x4 (&acc)[2][2][4][2], const pg8::Unit& u, int wr, int wc, int fr, int fq) const {
        const int row0 = u.pm * 256 + wr * 64 + fr, col0 = u.pn * 256 + wc * 32 + 8 * fq;
        const bool skip_p = (u.pn >= 4 && u.pn < 8) || (u.pn >= 30);
#pragma unroll
        for (int ai = 0; ai < 2; ++ai)
#pragma unroll
            for (int m = 0; m < 4; ++m) {
                bf16_t* rowp = P + (size_t)(row0 + ai * 128 + m * 16) * NIN + col0;
                if (!skip_p)
#pragma unroll
                for (int bj = 0; bj < 2; ++bj) {
                    const f32x4 a0 = acc[ai][bj][m][0], a1 = acc[ai][bj][m][1];
                    u32x4 w; w.x = pk2(a0[0], a0[1]); w.y = pk2(a0[2], a0[3]); w.z = pk2(a1[0], a1[1]); w.w = pk2(a1[2], a1[3]);
                    *(u32x4*)(rowp + bj * 128) = w;
                }
            }
        const bool is_hi = (u.pn >= 4 && u.pn < 8), is_nv = (u.pn >= 30);
        if (is_hi || is_nv) {
            bf16_t* TB = is_hi ? HIT : VT;
            const int cb = u.pn * 256 - (is_hi ? C_HI : C_NV) + wc * 32 + 8 * fq;
#pragma unroll
            for (int ai = 0; ai < 2; ++ai)
#pragma unroll
                for (int m = 0; m < 4; ++m) {
                    const int row = row0 + ai * 128 + m * 16;
#pragma unroll
                    for (int bj = 0; bj < 2; ++bj)
#pragma unroll
                        for (int n = 0; n < 2; ++n)
#pragma unroll
                            for (int j = 0; j < 4; ++j) TB[(size_t)(cb + bj * 128 + 4 * n + j) * T + row] = f2bf(acc[ai][bj][m][n][j]);
                }
        }
        if (u.pm < 16 && u.pn >= 28) {
            float* dst = (u.pn < 30) ? out_k : out_v;
            const int cb = u.pn * 256 - (u.pn < 30 ? C_NK : C_NV) + wc * 32 + 8 * fq;
#pragma unroll
            for (int ai = 0; ai < 2; ++ai)
#pragma unroll
                for (int m = 0; m < 4; ++m) {
                    const int row = row0 + ai * 128 + m * 16, b = row >> 8, s = row & 255;
                    float* rp = dst + ((size_t)((b * 2 + layer) * 256 + s)) * 512 + cb;
#pragma unroll
                    for (int bj = 0; bj < 2; ++bj) { *(f32x4*)(rp + bj * 128) = acc[ai][bj][m][0]; *(f32x4*)(rp + bj * 128 + 4) = acc[ai][bj][m][1]; }
                }
        }
    }
};
struct EpiResid {
    static constexpr bool PERM = false, AFTER_DRAIN = false;
    float* X; const float* gate; const float* xp; const float* xs;
    DI void operator()(const f32x4 (&acc)[2][2][4][2], const pg8::Unit& u, int wr, int wc, int fr, int fq) const {
        const int cond = u.pm < 16 ? 0 : 1 + ((u.pm - 16) >> 2);
        const int row0 = u.pm * 256 + wr * 64 + fr;
        const float* src = xp ? (u.pm < 16 ? xp : xs - (size_t)TP * D) : X;
        if (u.sp) {
            const int col0 = u.pn * 256 + u.kh * 128 + wc * 32 + 4 * fq;
            const float* gp = gate + (size_t)cond * 12288 + col0;
            const f32x4 g0 = *(const f32x4*)gp, g1 = *(const f32x4*)(gp + 16);
#pragma unroll
            for (int ai = 0; ai < 2; ++ai) {
                f32x4 xb[4][2];
#pragma unroll
                for (int m = 0; m < 4; ++m) {
                    const float* sp_ = src + (size_t)(row0 + ai * 128 + m * 16) * D + col0;
                    xb[m][0] = *(const f32x4*)sp_; xb[m][1] = *(const f32x4*)(sp_ + 16);
                }
#pragma unroll
                for (int m = 0; m < 4; ++m) {
                    float* dp = X + (size_t)(row0 + ai * 128 + m * 16) * D + col0;
                    *(f32x4*)dp = xb[m][0] + g0 * acc[ai][0][m][0]; *(f32x4*)(dp + 16) = xb[m][1] + g1 * acc[ai][0][m][1];
                }
            }
            return;
        }
        const int col0 = u.pn * 256 + wc * 32 + 4 * fq;
        const float* gp = gate + (size_t)cond * 12288 + col0;
        f32x4 gv[4];
#pragma unroll
        for (int q = 0; q < 4; ++q) gv[q] = *(const f32x4*)(gp + (q >> 1) * 128 + (q & 1) * 16);
#pragma unroll
        for (int hb = 0; hb < 3; ++hb) {
            const int r0 = 3 * hb, nr = hb < 2 ? 3 : 2;
            f32x4 xb[3][4];
#pragma unroll
            for (int rr = 0; rr < 3; ++rr)
                if (rr < nr) {
                    const int r = r0 + rr;
#pragma unroll
                    for (int q = 0; q < 4; ++q) xb[rr][q] = *(const f32x4*)(src + (size_t)(row0 + (r >> 2) * 128 + (r & 3) * 16) * D + col0 + (q >> 1) * 128 + (q & 1) * 16);
                }
#pragma unroll
            for (int rr = 0; rr < 3; ++rr)
                if (rr < nr) {
                    const int r = r0 + rr;
#pragma unroll
                    for (int q = 0; q < 4; ++q)
                        *(f32x4*)(X + (size_t)(row0 + (r >> 2) * 128 + (r & 3) * 16) * D + col0 + (q >> 1) * 128 + (q & 1) * 16) = xb[rr][q] + gv[q] * acc[r >> 2][q >> 1][r & 3][q & 1];
                }
        }
    }
};
struct EpiSwiGLU {
    static constexpr bool PERM = true, AFTER_DRAIN = false;
    bf16_t* U;
    DI void operator()(const f32x4 (&acc)[2][2][4][2], const pg8::Unit& u, int wr, int wc, int fr, int fq) const {
        const int row0 = u.pm * 256 + (u.sp == 2 ? u.kh * 128 : 0) + wr * 64 + fr, col0 = u.pn * 128 + wc * 32 + 8 * fq;
#pragma unroll
        for (int ai = 0; ai < 2; ++ai)
            if (ai == 0 || u.sp != 2)
#pragma unroll
            for (int m = 0; m < 4; ++m) {
                bf16_t* rowp = U + (size_t)(row0 + ai * 128 + m * 16) * FF + col0;
                f32x4 v0, v1;
#pragma unroll
                for (int j = 0; j < 4; ++j) { v0[j] = siluf_(acc[ai][0][m][0][j]) * acc[ai][1][m][0][j]; v1[j] = siluf_(acc[ai][0][m][1][j]) * acc[ai][1][m][1][j]; }
                u32x4 w; w.x = pk2(v0[0], v0[1]); w.y = pk2(v0[2], v0[3]); w.z = pk2(v1[0], v1[1]); w.w = pk2(v1[2], v1[3]);
                *(u32x4*)rowp = w;
            }
    }
};

DI void transpose_item(const float* __restrict__ W, int N, bf16_t* __restrict__ WT, int K, int k0, int n0, int drow0, LAS float* scr, int lane) {
#pragma unroll 8
    for (int i = 0; i < 32; ++i) { const int kk = 2 * i + (lane >> 5); scr[kk * 33 + (lane & 31)] = W[(size_t)(k0 + kk) * N + n0 + (lane & 31)]; }
    lds_wait();
    const int c = lane & 7;
#pragma unroll
    for (int j = 0; j < 4; ++j) {
        const int n = (lane >> 3) + 8 * j; const LAS float* s = scr + (8 * c) * 33 + n;
        u32x4 o; o.x = pk2(s[0 * 33], s[1 * 33]); o.y = pk2(s[2 * 33], s[3 * 33]); o.z = pk2(s[4 * 33], s[5 * 33]); o.w = pk2(s[6 * 33], s[7 * 33]);
        *(u32x4*)(WT + (size_t)(drow0 + n) * K + k0 + 8 * c) = o;
    }
    lds_wait();
}
DI void transpose_matrix(const float* W, int K, int N, bf16_t* WT, int mode, LAS float* scr, int gw, int NGW, int lane) {
    const int nblk = N / 32, nitems = (K / 64) * nblk;
    for (int it = gw; it < nitems; it += NGW) {
        const int kb = it / nblk, nb = it % nblk, n0 = nb * 32;
        const int drow0 = mode == 0 ? n0 : ((n0 >> 7) * 256 + (n0 & 127) + (mode == 2 ? 128 : 0));
        transpose_item(W, N, WT, K, kb * 64, n0, drow0, scr, lane);
    }
}
DI void adaln_item(const Prm& p, LAS unsigned char* L, int item) {
    const int l = item / 96, cgp = item % 96;
    const int tid = opaque_tid(), wave = tid >> 6, lane = tid & 63;
    const float* cvec = p.in[5]; const float* cctx = p.in[6]; const float* w_ada = p.in[7]; const float* b_ada = p.in[8];
    float* MOD = (float*)(p.ws + WS_MOD);
    LAS float* SC = (LAS float*)L + wave * 256 * 12;
    for (int kk = lane; kk < 256; kk += 64) {
        const int k = wave * 256 + kk;
#pragma unroll
        for (int c = 0; c < 9; ++c) { const float v = c == 0 ? cctx[k] : cvec[(c - 1) * 2048 + k]; SC[kk * 12 + c] = siluf_(v); }
    }
    lds_wait();
    float acc[9][2];
#pragma unroll
    for (int c = 0; c < 9; ++c) { acc[c][0] = 0.f; acc[c][1] = 0.f; }
    const float* wp = w_ada + ((size_t)l * 2048 + wave * 256) * 12288 + cgp * 128 + 2 * lane;
#pragma unroll 8
    for (int kk = 0; kk < 256; ++kk) {
        const f32x2 w = *(const f32x2*)(wp + (size_t)kk * 12288);
        const f32x4 s0 = *(const LAS f32x4*)(SC + kk * 12), s1 = *(const LAS f32x4*)(SC + kk * 12 + 4); const float s8 = SC[kk * 12 + 8];
#pragma unroll
        for (int c = 0; c < 4; ++c) { acc[c][0] += s0[c] * w.x; acc[c][1] += s0[c] * w.y; acc[4 + c][0] += s1[c] * w.x; acc[4 + c][1] += s1[c] * w.y; }
        acc[8][0] += s8 * w.x; acc[8][1] += s8 * w.y;
    }
    __syncthreads();
    LAS float* RED = (LAS float*)L;
#pragma unroll
    for (int c = 0; c < 9; ++c) { RED[(wave * 9 + c) * 128 + 2 * lane] = acc[c][0]; RED[(wave * 9 + c) * 128 + 2 * lane + 1] = acc[c][1]; }
    __syncthreads();
    for (int idx = tid; idx < 9 * 128; idx += 512) {
        const int c = idx >> 7, col = idx & 127; float s = 0.f;
#pragma unroll
        for (int w = 0; w < 8; ++w) s += RED[(w * 9 + c) * 128 + col];
        MOD[((size_t)l * 9 + c) * 12288 + cgp * 128 + col] = s + b_ada[(size_t)l * 12288 + cgp * 128 + col];
    }
    __syncthreads();
}
DI void prologue_phase(const Prm& p, LAS unsigned char* L) {
    const int tid = opaque_tid(), wave = tid >> 6, lane = tid & 63;
    const int G = gridDim.x, gw = blockIdx.x * 8 + wave, NGW = G * 8;
    if (blockIdx.x == 0 && tid < 64) ((unsigned*)(p.ws + WS_FLG))[tid] = 0u;
    for (int it = blockIdx.x; it < 192; it += G) adaln_item(p, L, it);
    {
        const float* ck = p.in[2]; const float* cv = p.in[3];
        bf16_t* KC = (bf16_t*)(p.ws + WS_KC); bf16_t* VCT = (bf16_t*)(p.ws + WS_VCT);
        const int gt = blockIdx.x * 512 + tid, NT = G * 512;
        for (int ci = gt; ci < 524288; ci += NT) {
            const int row = ci >> 4, dc = ci & 15, bl = row >> 11, key = (row >> 2) & 511, h = row & 3;
            const f32x4 a = *(const f32x4*)(ck + (size_t)row * 128 + dc * 8), b = *(const f32x4*)(ck + (size_t)row * 128 + dc * 8 + 4);
            u32x4 o; o.x = pk2(a[0], a[1]); o.y = pk2(a[2], a[3]); o.z = pk2(b[0], b[1]); o.w = pk2(b[2], b[3]);
            *(u32x4*)(KC + ((size_t)((bl * 4 + h) * 512 + key)) * 128 + dc * 8) = o;
        }
        for (int ci = gt; ci < 524288; ci += NT) {
            const int d = ci & 127, kc = (ci >> 7) & 63, h = (ci >> 13) & 3, bl = ci >> 15;
            float v[8];
#pragma unroll
            for (int e = 0; e < 8; ++e) v[e] = cv[((size_t)(bl * 512 + kc * 8 + e) * 4 + h) * 128 + d];
            u32x4 o; o.x = pk2(v[0], v[1]); o.y = pk2(v[2], v[3]); o.z = pk2(v[4], v[5]); o.w = pk2(v[6], v[7]);
            *(u32x4*)(VCT + ((size_t)((bl * 4 + h) * 128 + d)) * 512 + kc * 8) = o;
        }
    }
    LAS float* scr = (LAS float*)L + wave * (64 * 33);
    for (int l = 0; l < 2; ++l) {
        transpose_matrix(p.in[10] + (size_t)l * D * NIN, D, NIN, (bf16_t*)(p.ws + WS_WIN) + (size_t)l * NIN * D, 0, scr, gw, NGW, lane);
        transpose_matrix(p.in[15] + (size_t)l * D * D, D, D, (bf16_t*)(p.ws + WS_WOUT) + (size_t)l * D * D, 0, scr, gw, NGW, lane);
        transpose_matrix(p.in[17] + (size_t)l * D * FF, D, FF, (bf16_t*)(p.ws + WS_WGU) + (size_t)l * NGU * D, 1, scr, gw, NGW, lane);
        transpose_matrix(p.in[18] + (size_t)l * D * FF, D, FF, (bf16_t*)(p.ws + WS_WGU) + (size_t)l * NGU * D, 2, scr, gw, NGW, lane);
        transpose_matrix(p.in[19] + (size_t)l * FF * D, FF, D, (bf16_t*)(p.ws + WS_WD) + (size_t)l * D * FF, 0, scr, gw, NGW, lane);
    }
}

DI void norm_phase(const Prm& p, int l, int which, bool copy_in) {
    const int tid = opaque_tid(), wave = tid >> 6, lane = tid & 63;
    const int gw = blockIdx.x * 8 + wave, NGW = gridDim.x * 8;
    float* X = (float*)(p.ws + WS_X); bf16_t* H = (bf16_t*)(p.ws + WS_H);
    const float* nw = which == 0 ? p.in[9] + l * D : (which == 1 ? p.in[16] + l * D : p.in[20]);
    const float* MOD = (const float*)(p.ws + WS_MOD) + (size_t)l * 9 * 12288 + (which == 1 ? 6144 : 0);
    const int rpw = (T + NGW - 1) / NGW, r_lo = gw * rpw, r_hi = min(T, r_lo + rpw);
    f32x4 cw[8], sh[8];
    int cur_cond = -1;
    for (int rb = r_lo; rb < r_hi; rb += 3) {
        {
            const int cond = rb < TP ? 0 : 1 + ((rb - TP) >> 10);
            if (cond != cur_cond) {
                cur_cond = cond;
                const float* shp = MOD + (size_t)cond * 12288; const float* scp = shp + 2048;
                f32x4 wv[8], sv[8];
#pragma unroll
                for (int j = 0; j < 8; ++j) { const int c = 4 * lane + 256 * j; wv[j] = *(const f32x4*)(nw + c); sv[j] = which == 2 ? (f32x4){0.f, 0.f, 0.f, 0.f} : *(const f32x4*)(scp + c); sh[j] = which == 2 ? (f32x4){0.f, 0.f, 0.f, 0.f} : *(const f32x4*)(shp + c); }
#pragma unroll
                for (int j = 0; j < 8; ++j) cw[j] = wv[j] * (1.f + sv[j]);
            }
        }
        f32x4 v[3][8];
#pragma unroll
        for (int q = 0; q < 3; ++q) {
            const int row = min(rb + q, r_hi - 1);
            const float* xr = copy_in ? (row < TP ? p.in[0] + (size_t)row * D : p.in[1] + (size_t)(row - TP) * D) : X + (size_t)row * D;
#pragma unroll
            for (int j = 0; j < 8; ++j) v[q][j] = *(const f32x4*)(xr + 4 * lane + 256 * j);
        }
#pragma unroll
        for (int q = 0; q < 3; ++q) {
            const int row = rb + q;
            if (row < r_hi) {
                const int cond = row < TP ? 0 : 1 + ((row - TP) >> 10);
                if (cond != cur_cond) {
                    cur_cond = cond;
                    const float* shp = MOD + (size_t)cond * 12288; const float* scp = shp + 2048;
#pragma unroll
                    for (int j = 0; j < 8; ++j) {
                        const int c = 4 * lane + 256 * j; const f32x4 w = *(const f32x4*)(nw + c);
                        if (which == 2) { cw[j] = w; sh[j] = (f32x4){0.f, 0.f, 0.f, 0.f}; }
                        else { cw[j] = w * (1.f + *(const f32x4*)(scp + c)); sh[j] = *(const f32x4*)(shp + c); }
                    }
                }
                float ss = 0.f;
#pragma unroll
                for (int j = 0; j < 8; ++j) ss += (v[q][j][0] * v[q][j][0] + v[q][j][1] * v[q][j][1]) + (v[q][j][2] * v[q][j][2] + v[q][j][3] * v[q][j][3]);
                ss = wave_sum(ss, lane);
                const float rstd = rsqrtf(ss * (1.f / D) + EPS);
                if (which == 2) {
#pragma unroll
                    for (int j = 0; j < 8; ++j) *(f32x4*)(p.out + O_Y + (size_t)row * D + 4 * lane + 256 * j) = v[q][j] * rstd * cw[j];
                } else {
#pragma unroll
                    for (int j = 0; j < 8; ++j) {
                        const f32x4 hv = (v[q][j] * rstd) * cw[j] + sh[j];
                        u32x2 o; o.x = pk2(hv[0], hv[1]); o.y = pk2(hv[2], hv[3]);
                        *(u32x2*)(H + (size_t)row * D + 4 * lane + 256 * j) = o;
                    }
                }
            }
        }
    }
}
DI void combine_phase(const Prm& p, int l) {
    const int tid = opaque_tid(), wave = tid >> 6, lane = tid & 63;
    const int gw = blockIdx.x * 8 + wave, NGW = gridDim.x * 8;
    const bf16_t* P = (const bf16_t*)(p.ws + WS_P); bf16_t* MIX = (bf16_t*)(p.ws + WS_MIX);
    const bf16_t* OF = (const bf16_t*)(p.ws + WS_OF); const bf16_t* OB = (const bf16_t*)(p.ws + WS_OB);
    const float* gw_ = p.in[12] + l * 128; const float* cwp = p.in[13] + (size_t)l * 3 * 512;
    const int v0 = (lane & 15) * 8, c0 = lane * 8;
    const f32x4 gw0 = *(const f32x4*)(gw_ + v0), gw1 = *(const f32x4*)(gw_ + v0 + 4);
    float cwt[3][8];
#pragma unroll
    for (int k = 0; k < 3; ++k)
#pragma unroll
        for (int e = 0; e < 8; ++e) cwt[k][e] = cwp[k * 512 + c0 + e];
    const int tpw = (T + NGW - 1) / NGW, t_lo = gw * tpw, t_hi = min(T, t_lo + tpw);
    const u32x4 zero = {0u, 0u, 0u, 0u};
    for (int tb = t_lo; tb < t_hi; tb += 2) {
        u32x4 a[2][2], bq[2][2]; u32x4 gg[2][2], cb[2], cc[2][3], cx[2][3];
#pragma unroll
        for (int q = 0; q < 2; ++q) {
            const int tok = min(tb + q, t_hi - 1);
            const bf16_t* pr = P + (size_t)tok * NIN;
#pragma unroll
            for (int ps = 0; ps < 2; ++ps) {
                const int col = (4 * ps + (lane >> 4)) * 128 + v0;
                a[q][ps] = *(const u32x4*)(OF + (size_t)tok * 1024 + col); bq[q][ps] = *(const u32x4*)(OB + (size_t)tok * 1024 + col);
                gg[q][ps] = *(const u32x4*)(pr + C_HG + col);
            }
            const int pos = tok < TP ? (tok & 255) : ((tok - TP) & 1023), len = tok < TP ? 256 : 1024;
            const bool hp = pos > 0, hn = pos < len - 1;
            cb[q] = *(const u32x4*)(pr + C_CB + c0);
            cc[q][1] = *(const u32x4*)(pr + C_CC + c0); cx[q][1] = *(const u32x4*)(pr + C_CX + c0);
            cc[q][0] = hp ? *(const u32x4*)(pr - NIN + C_CC + c0) : zero; cx[q][0] = hp ? *(const u32x4*)(pr - NIN + C_CX + c0) : zero;
            cc[q][2] = hn ? *(const u32x4*)(pr + NIN + C_CC + c0) : zero; cx[q][2] = hn ? *(const u32x4*)(pr + NIN + C_CX + c0) : zero;
        }
#pragma unroll
        for (int q = 0; q < 2; ++q) {
            const int tok = tb + q;
            if (tok < t_hi) {
#pragma unroll
                for (int ps = 0; ps < 2; ++ps) {
                    const int col = (4 * ps + (lane >> 4)) * 128 + v0;
                    const u32x4 af = a[q][ps], bf_ = bq[q][ps];
                    const f32x4 o0 = {bflo(af.x) + bflo(bf_.x), bfhi(af.x) + bfhi(bf_.x), bflo(af.y) + bflo(bf_.y), bfhi(af.y) + bfhi(bf_.y)};
                    const f32x4 o1 = {bflo(af.z) + bflo(bf_.z), bfhi(af.z) + bfhi(bf_.z), bflo(af.w) + bflo(bf_.w), bfhi(af.w) + bfhi(bf_.w)};
                    float ss = (o0[0] * o0[0] + o0[1] * o0[1]) + (o0[2] * o0[2] + o0[3] * o0[3]) + (o1[0] * o1[0] + o1[1] * o1[1]) + (o1[2] * o1[2] + o1[3] * o1[3]);
                    ss += shx(ss, 1, lane); ss += shx(ss, 2, lane); ss += shx(ss, 4, lane); ss += shx(ss, 8, lane);
                    const float rstd = rsqrtf(ss * (1.f / 128.f) + EPS);
                    const u32x4 g = gg[q][ps];
                    float r[8];
                    r[0] = o0[0] * rstd * gw0[0] * siluf_(bflo(g.x)); r[1] = o0[1] * rstd * gw0[1] * siluf_(bfhi(g.x));
                    r[2] = o0[2] * rstd * gw0[2] * siluf_(bflo(g.y)); r[3] = o0[3] * rstd * gw0[3] * siluf_(bfhi(g.y));
                    r[4] = o1[0] * rstd * gw1[0] * siluf_(bflo(g.z)); r[5] = o1[1] * rstd * gw1[1] * siluf_(bfhi(g.z));
                    r[6] = o1[2] * rstd * gw1[2] * siluf_(bflo(g.w)); r[7] = o1[3] * rstd * gw1[3] * siluf_(bfhi(g.w));
                    u32x4 o; o.x = pk2(r[0], r[1]); o.y = pk2(r[2], r[3]); o.z = pk2(r[4], r[5]); o.w = pk2(r[6], r[7]);
                    *(u32x4*)(MIX + (size_t)tok * D + col) = o;
                }
                float r[8];
#pragma unroll
                for (int e = 0; e < 4; ++e) {
                    r[2 * e] = bflo(cb[q][e]) * (bflo(cc[q][0][e]) * bflo(cx[q][0][e]) * cwt[0][2 * e] + bflo(cc[q][1][e]) * bflo(cx[q][1][e]) * cwt[1][2 * e] + bflo(cc[q][2][e]) * bflo(cx[q][2][e]) * cwt[2][2 * e]);
                    r[2 * e + 1] = bfhi(cb[q][e]) * (bfhi(cc[q][0][e]) * bfhi(cx[q][0][e]) * cwt[0][2 * e + 1] + bfhi(cc[q][1][e]) * bfhi(cx[q][1][e]) * cwt[1][2 * e + 1] + bfhi(cc[q][2][e]) * bfhi(cx[q][2][e]) * cwt[2][2 * e + 1]);
                }
                u32x4 o; o.x = pk2(r[0], r[1]); o.y = pk2(r[2], r[3]); o.z = pk2(r[4], r[5]); o.w = pk2(r[6], r[7]);
                *(u32x4*)(MIX + (size_t)tok * D + 1024 + c0) = o;
            }
        }
    }
}

template <int TG> DI void scan_consts(const LAS float* TOT, int lane, float E80, float (&Ceb)[2], float (&Cek)[2], float (&Aed)[2], float (&Aen)[2], float (&Gall)[2]) {
    float pre[2] = {1.f, 1.f}, post[2] = {1.f, 1.f}, mid[2] = {1.f, 1.f}, own[2] = {1.f, 1.f};
#pragma unroll
    for (int gq = 0; gq < 8; ++gq) {
        const f32x2 gt = *(const LAS f32x2*)(TOT + gq * 128 + 2 * lane);
        const bool inmid = TG >= 4 ? (gq >= 4 && gq < TG) : (gq > TG && gq <= 3);
#pragma unroll
        for (int ch = 0; ch < 2; ++ch) {
            const float gv = gt[ch];
            if (gq < TG) pre[ch] *= gv;
            if (gq > TG) post[ch] *= gv;
            if (inmid) mid[ch] *= gv;
            if (gq == TG) own[ch] = gv;
        }
    }
#pragma unroll
    for (int ch = 0; ch < 2; ++ch) {
        Ceb[ch] = pre[ch]; Cek[ch] = own[ch] * post[ch]; Gall[ch] = pre[ch] * own[ch] * post[ch];
        if (TG >= 4) { Aed[ch] = mid[ch]; Aen[ch] = fminf(__builtin_amdgcn_rcpf(mid[ch]), E80); }
        else { Aen[ch] = own[ch] * mid[ch]; Aed[ch] = fminf(__builtin_amdgcn_rcpf(Aen[ch]), E80); }
    }
}
constexpr int SC_QI = 0, SC_QP = 8448, SC_KP = SC_QP + 8704, SC_KHT = SC_KP + 8704, SC_VTS = SC_KHT + 10240, SC_EBL = SC_VTS + 10240, SC_TOT = SC_EBL + 512, SC_XCH = SC_TOT + 4096, SC_END = SC_XCH + 16384;
DI void scan_item(const Prm& p, LAS unsigned char* L, int l, int stream, int b, int h, int dir) {
    const int tid = opaque_tid(), lane = tid & 63;
    const int wave = __builtin_amdgcn_readfirstlane(tid >> 6), wq = wave & 3, kp = wave >> 2, tg = wave;
    const int N = stream ? 1024 : 256, row0 = stream ? TP + b * 1024 : b * 256;
    LAS unsigned char* QI = L + SC_QI; LAS unsigned char* QP = L + SC_QP; LAS unsigned char* KP = L + SC_KP; LAS unsigned char* KHT = L + SC_KHT; LAS unsigned char* VTS = L + SC_VTS;
    LAS float* EBL = (LAS float*)(L + SC_EBL); LAS float* TOT = (LAS float*)(L + SC_TOT); LAS float* XCH = (LAS float*)(L + SC_XCH);
    const bf16_t* P = (const bf16_t*)(p.ws + WS_P); const bf16_t* HIT = (const bf16_t*)(p.ws + WS_HIT);
    bf16_t* OO = (bf16_t*)(p.ws + (dir ? WS_OB : WS_OF));
    float lb[2] = {0.f, 0.f};
    if (l == 1) {
        const float* raw = p.in[11];
#pragma unroll
        for (int ch = 0; ch < 2; ++ch) { const int k = h * 128 + 2 * lane + ch; const float r0 = raw[(dir * 2 + 0) * 1024 + k], r1 = raw[(dir * 2 + 1) * 1024 + k]; lb[ch] = 1.f / (1.f + __expf(r0 - r1)); }
    }
    const int n31 = lane & 31, hh = lane >> 5, vcol = 32 * wq + n31;
    f32x16 S[4];
#pragma unroll
    for (int kt = 0; kt < 4; ++kt)
#pragma unroll
        for (int r = 0; r < 16; ++r) S[kt][r] = 0.f;
    if (stream) {
        const float* sp = p.in[4] + ((((size_t)b * 2 + l) * 2 + dir) * 8 + h) * 16384;
#pragma unroll
        for (int kt = 0; kt < 4; ++kt)
            if ((kt == 0) == (kp == 0)) {
#pragma unroll
                for (int r = 0; r < 16; ++r) S[kt][r] = sp[(32 * kt + crow(r, hh)) * 128 + vcol];
            }
    }
    const bf16_t* Pq = P + (size_t)row0 * NIN + C_HQ + h * 128 + 2 * lane;
    const bf16_t* Pf = P + (size_t)row0 * NIN + (dir ? C_HFB : C_HFF) + h * 128 + 2 * lane;
    const int vv = tid & 127, vp = tid >> 7;
    const bf16_t* Hv = HIT + (size_t)(h * 128 + vv) * T + row0;
    const int nchunk = N / 32, ostride = dir ? -1024 : 1024;
    unsigned xr[4], qr[4]; u32x4 va;
    auto load_chunk = [&](int c) {
#pragma unroll
        for (int t = 0; t < 4; ++t) {
            const int i = 32 * c + 4 * tg + t, tok = dir ? N - 1 - i : i;
            xr[t] = *(const unsigned*)(Pf + (size_t)tok * NIN); qr[t] = *(const unsigned*)(Pq + (size_t)tok * NIN);
        }
        va = *(const u32x4*)(dir ? Hv + N - 32 * c - 8 * vp - 8 : Hv + 32 * c + 8 * vp);
    };
    load_chunk(0);
    const float E80 = 5.5e34f;
    float c30 = 30.f; asm volatile("" : "+v"(c30));
    for (int c = 0; c < nchunk; ++c) {
        float lp[2][4], kk[2][4], qv[2][4];
#pragma unroll
        for (int t = 0; t < 4; ++t)
#pragma unroll
            for (int ch = 0; ch < 2; ++ch) {
                float x = ch ? bfhi(xr[t]) : bflo(xr[t]); qv[ch][t] = (ch ? bfhi(qr[t]) : bflo(qr[t])) * QSCALE;
                x = fminf(fmaxf(x, -c30), c30);
                const float e = __expf(-x), inv = __builtin_amdgcn_rcpf(1.f + e);
                lp[ch][t] = (1.f + lb[ch] * e) * inv;
                kk[ch][t] = (1.f - lb[ch]) * e * inv;
            }
#pragma unroll
        for (int ch = 0; ch < 2; ++ch) {
#pragma unroll
            for (int t = 1; t < 4; ++t) lp[ch][t] *= lp[ch][t - 1];
        }
        { f32x2 tt = {lp[0][3], lp[1][3]}; *(LAS f32x2*)(TOT + tg * 128 + 2 * lane) = tt; }
        {
            u32x4 w = va;
            if (dir) { w.x = (va.w >> 16) | (va.w << 16); w.y = (va.z >> 16) | (va.z << 16); w.z = (va.y >> 16) | (va.y << 16); w.w = (va.x >> 16) | (va.x << 16); }
            *(LAS u32x4*)(VTS + vv * 80 + 16 * vp) = w;
        }
        __syncthreads();
        float Ceb[2], Cek[2], Aed[2], Aen[2], Gall[2];
        switch (tg) {
            case 0: scan_consts<0>(TOT, lane, E80, Ceb, Cek, Aed, Aen, Gall); break;
            case 1: scan_consts<1>(TOT, lane, E80, Ceb, Cek, Aed, Aen, Gall); break;
            case 2: scan_consts<2>(TOT, lane, E80, Ceb, Cek, Aed, Aen, Gall); break;
            case 3: scan_consts<3>(TOT, lane, E80, Ceb, Cek, Aed, Aen, Gall); break;
            case 4: scan_consts<4>(TOT, lane, E80, Ceb, Cek, Aed, Aen, Gall); break;
            case 5: scan_consts<5>(TOT, lane, E80, Ceb, Cek, Aed, Aen, Gall); break;
            case 6: scan_consts<6>(TOT, lane, E80, Ceb, Cek, Aed, Aen, Gall); break;
            default: scan_consts<7>(TOT, lane, E80, Ceb, Cek, Aed, Aen, Gall); break;
        }
        float khv[2][4];
#pragma unroll
        for (int t = 0; t < 4; ++t) {
            const int ii = 4 * tg + t;
            float eb[2], ed[2], en[2];
#pragma unroll
            for (int ch = 0; ch < 2; ++ch) {
                const float l_ = lp[ch][t], rt = fminf(__builtin_amdgcn_rcpf(l_), E80);
                eb[ch] = l_ * Ceb[ch]; ed[ch] = l_ * Aed[ch]; en[ch] = fminf(rt * Aen[ch], E80);
                khv[ch][t] = kk[ch][t] * (rt * Cek[ch]);
            }
            *(LAS unsigned*)(QI + ii * 264 + 4 * lane) = pk2(qv[0][t] * eb[0], qv[1][t] * eb[1]);
            *(LAS unsigned*)(QP + ii * 272 + 4 * lane) = pk2(qv[0][t] * ed[0], qv[1][t] * ed[1]);
            *(LAS unsigned*)(KP + ii * 272 + 4 * lane) = pk2(kk[0][t] * en[0], kk[1][t] * en[1]);
        }
#pragma unroll
        for (int ch = 0; ch < 2; ++ch) { u32x2 w; w.x = pk2(khv[ch][0], khv[ch][1]); w.y = pk2(khv[ch][2], khv[ch][3]); *(LAS u32x2*)(KHT + (2 * lane + ch) * 80 + 8 * tg) = w; }
        if (tg == 0) { f32x2 e2 = {Gall[0], Gall[1]}; *(LAS f32x2*)(EBL + 2 * lane) = e2; }
        __syncthreads();
        if (c + 1 < nchunk) load_chunk(c + 1);
        f32x16 ao;
#pragma unroll
        for (int r = 0; r < 16; ++r) ao[r] = 0.f;
#pragma unroll
        for (int kt = 0; kt < 4; ++kt)
            if ((kt == 0) == (kp == 0)) {
#pragma unroll
                for (int s = 0; s < 2; ++s) {
                    const bf16x8 Bf = pack8(S[kt], s);
                    const int k0 = 32 * kt + 16 * s + 4 * hh;
                    const s16x4 lo = *(const LAS s16x4*)(QI + n31 * 264 + 2 * k0), hi = *(const LAS s16x4*)(QI + n31 * 264 + 2 * (k0 + 8));
                    ao = MFMA32(cat4(lo, hi), Bf, ao);
                }
            }
        if (kp == 0) {
            f32x16 X0, X1;
#pragma unroll
            for (int r = 0; r < 16; ++r) { X0[r] = 0.f; X1[r] = 0.f; }
#pragma unroll
            for (int ks = 0; ks < 8; ks += 2) {
                const bf16x8 A0 = *(const LAS bf16x8*)(KP + n31 * 272 + 2 * (16 * ks + 8 * hh)), B0 = *(const LAS bf16x8*)(QP + n31 * 272 + 2 * (16 * ks + 8 * hh));
                const bf16x8 A1 = *(const LAS bf16x8*)(KP + n31 * 272 + 2 * (16 * ks + 16 + 8 * hh)), B1 = *(const LAS bf16x8*)(QP + n31 * 272 + 2 * (16 * ks + 16 + 8 * hh));
                X0 = MFMA32(A0, B0, X0); X1 = MFMA32(A1, B1, X1);
            }
#pragma unroll
            for (int r = 0; r < 16; ++r) X0[r] = (crow(r, hh) <= n31) ? X0[r] + X1[r] : 0.f;
#pragma unroll
            for (int s = 0; s < 2; ++s) {
                const bf16x8 Af = pack8(X0, s);
                const int j0 = 16 * s + 4 * hh;
                const s16x4 lo = *(const LAS s16x4*)(VTS + vcol * 80 + 2 * j0), hi = *(const LAS s16x4*)(VTS + vcol * 80 + 2 * (j0 + 8));
                ao = MFMA32(Af, cat4(lo, hi), ao);
            }
        }
#pragma unroll
        for (int kt = 0; kt < 4; ++kt)
            if ((kt == 0) == (kp == 0)) {
#pragma unroll
                for (int g = 0; g < 4; ++g) {
                    const f32x4 e = *(const LAS f32x4*)(EBL + 32 * kt + 8 * g + 4 * hh);
#pragma unroll
                    for (int j = 0; j < 4; ++j) S[kt][4 * g + j] *= e[j];
                }
#pragma unroll
                for (int s = 0; s < 2; ++s) {
                    const bf16x8 Af = *(const LAS bf16x8*)(KHT + (32 * kt + n31) * 80 + 2 * (16 * s + 8 * hh));
                    const bf16x8 Bf = *(const LAS bf16x8*)(VTS + vcol * 80 + 2 * (16 * s + 8 * hh));
                    S[kt] = MFMA32(Af, Bf, S[kt]);
                }
            }
        if (kp == 1) {
#pragma unroll
            for (int g = 0; g < 4; ++g) { f32x4 v = {ao[4 * g], ao[4 * g + 1], ao[4 * g + 2], ao[4 * g + 3]}; *(LAS f32x4*)(XCH + wq * 1024 + g * 256 + lane * 4) = v; }
        }
        __syncthreads();
        if (kp == 0) {
            const int i0 = 32 * c + 4 * hh, tok0 = dir ? N - 1 - i0 : i0;
            bf16_t* ob = OO + (size_t)(row0 + tok0) * 1024 + h * 128 + vcol;
#pragma unroll
            for (int g = 0; g < 4; ++g) {
                const f32x4 v = *(const LAS f32x4*)(XCH + wq * 1024 + g * 256 + lane * 4);
#pragma unroll
                for (int j = 0; j < 4; ++j) ob[(j + 8 * g) * ostride] = f2bf(ao[4 * g + j] + v[j]);
            }
        }
    }
    if (!stream) {
        float* so = p.out + O_ST + ((((size_t)b * 2 + l) * 2 + dir) * 8 + h) * 16384;
#pragma unroll
        for (int kt = 0; kt < 4; ++kt)
            if ((kt == 0) == (kp == 0)) {
#pragma unroll
                for (int r = 0; r < 16; ++r) so[(32 * kt + crow(r, hh)) * 128 + vcol] = S[kt][r];
            }
    }
    __syncthreads();
}

constexpr int AT_KS = 0, AT_VS = 17408, AT_HALF = 35840, AT_RPB = 2 * AT_HALF, AT_END = AT_RPB + 4096;
constexpr float LOG2E = 1.4426950408889634f;
DI void attn_item(const Prm& p, LAS unsigned char* L, int l, int item) {
    const int tid = opaque_tid(), wave = tid >> 6, lane = tid & 63, kh = wave >> 2, qg = wave & 3, td = tid & 255;
    const int n16 = lane & 15, g = lane >> 4;
    float l2e_ = LOG2E; asm volatile("" : "+v"(l2e_));
    const bf16_t* P = (const bf16_t*)(p.ws + WS_P); const bf16_t* VT = (const bf16_t*)(p.ws + WS_VT);
    const bf16_t* KC = (const bf16_t*)(p.ws + WS_KC); const bf16_t* VCT = (const bf16_t*)(p.ws + WS_VCT);
    bf16_t* MIX = (bf16_t*)(p.ws + WS_MIX);
    const bool na = item >= 256;
    int b, h, qrow0, ntl, rq = 0, rs = 0;
    if (!na) { b = item >> 4; h = (item >> 2) & 3; qrow0 = b * 256 + (item & 3) * 64; ntl = 2; }
    else { const int it = item - 256; b = it >> 6; h = (it >> 4) & 3; rq = it & 15; qrow0 = TP + b * 1024 + rq * 64; ntl = 8; rs = min(max(rq - 4, 0), 8); }
    LAS unsigned char* KS = L + kh * AT_HALF + AT_KS; LAS unsigned char* VS = L + kh * AT_HALF + AT_VS;
    LAS float* RPB = (LAS float*)(L + AT_RPB) + 64;
    const bool band = na && kh == 0;
    unsigned vmask = 0xffffu; int dcb = 0, nt_lo = 0, nt_hi = 3;
    float mk[16];
#pragma unroll
    for (int i = 0; i < 16; ++i) mk[i] = 0.f;
    if (band) {
        const int qc = 16 * qg + n16, cs = min(max(qc - 8, 0), 48);
        vmask = 0u;
#pragma unroll
        for (int nt = 0; nt < 4; ++nt)
#pragma unroll
            for (int r = 0; r < 4; ++r) { const int kc = 16 * nt + 4 * g + r; const bool ok = kc >= cs && kc < cs + 16; if (ok) vmask |= 1u << (4 * nt + r); mk[4 * nt + r] = ok ? 0.f : -1e30f; }
        dcb = 4 * g - qc + 15;
        nt_lo = max(qg - 1, 0); nt_hi = min(qg + 1, 3);
    }
    bf16x8 Qf[4];
    { const bf16_t* qp = P + (size_t)(qrow0 + 16 * qg + n16) * NIN + C_NQ + h * 128 + 8 * g;
#pragma unroll
      for (int ks = 0; ks < 4; ++ks) Qf[ks] = *(const bf16x8*)(qp + 32 * ks); }
    f32x4 O[8];
#pragma unroll
    for (int dt = 0; dt < 8; ++dt) O[dt] = (f32x4){0.f, 0.f, 0.f, 0.f};
    float mrun = -1e30f, lsum = 0.f;
    u32x4 kr[4], vr[4];
    auto load_tile = [&](int t) {
        const bf16_t* ksrc; const bf16_t* vsrc; int ldk, ldv;
        if (!na) { const int kt = 2 * kh + t; ksrc = P + (size_t)(b * 256 + kt * 64) * NIN + C_NK + h * 128; ldk = NIN; vsrc = VT + (size_t)(h * 128) * T + b * 256 + kt * 64; ldv = T; }
        else if (kh == 0) { const int tr = TP + b * 1024 + (rs + t) * 64; ksrc = P + (size_t)tr * NIN + C_NK + h * 128; ldk = NIN; vsrc = VT + (size_t)(h * 128) * T + tr; ldv = T; }
        else { const size_t bh = (size_t)((b * 2 + l) * 4 + h); ksrc = KC + bh * 65536 + (size_t)t * 64 * 128; ldk = 128; vsrc = VCT + bh * 65536 + t * 64; ldv = 512; }
#pragma unroll
        for (int i = 0; i < 4; ++i) {
            const int id = td + 256 * i;
            kr[i] = *(const u32x4*)(ksrc + (size_t)(id >> 4) * ldk + (id & 15) * 8);
            vr[i] = *(const u32x4*)(vsrc + (size_t)(id >> 3) * ldv + (id & 7) * 8);
        }
    };
    load_tile(0);
    if (na) { const float* rp = p.in[14] + (size_t)(l * 4 + h) * 465; for (int i = tid; i < 465; i += 512) RPB[i] = rp[i]; if (tid < 64) { RPB[tid - 64] = 0.f; RPB[465 + tid] = 0.f; } }
    for (int t = 0; t < ntl; ++t) {
        __syncthreads();
#pragma unroll
        for (int i = 0; i < 4; ++i) {
            const int id = td + 256 * i;
            *(LAS u32x4*)(KS + (id >> 4) * 272 + (id & 15) * 16) = kr[i];
            *(LAS u32x4*)(VS + (id >> 3) * 144 + (id & 7) * 16) = vr[i];
        }
        __syncthreads();
        if (t + 1 < ntl) load_tile(t + 1);
        f32x4 Sx[4];
#pragma unroll
        for (int nt = 0; nt < 4; ++nt) {
            Sx[nt] = (f32x4){0.f, 0.f, 0.f, 0.f};
            if (nt >= nt_lo && nt <= nt_hi) {
#pragma unroll
                for (int ks = 0; ks < 4; ++ks) {
                    const bf16x8 Af = *(const LAS bf16x8*)(KS + (16 * nt + n16) * 272 + 2 * (32 * ks + 8 * g));
                    Sx[nt] = MFMA16(Af, Qf[ks], Sx[nt]);
                }
            }
        }
        if (band) {
            const LAS float* rb = RPB + (rs + t - rq + 7) * 31 + dcb;
#pragma unroll
            for (int nt = 0; nt < 4; ++nt)
#pragma unroll
                for (int r = 0; r < 4; ++r) Sx[nt][r] = (Sx[nt][r] * QSCALE + rb[16 * nt + r]) + mk[4 * nt + r];
        } else {
#pragma unroll
            for (int nt = 0; nt < 4; ++nt) Sx[nt] = Sx[nt] * QSCALE;
        }
        float mx = -1e30f;
#pragma unroll
        for (int nt = 0; nt < 4; ++nt) mx = fmaxf(mx, fmaxf(fmaxf(Sx[nt][0], Sx[nt][1]), fmaxf(Sx[nt][2], Sx[nt][3])));
        if (__builtin_amdgcn_ballot_w64(mx > mrun + 8.f) != 0ull) {
            mx = fmaxf(mx, shx(mx, 16, lane)); mx = fmaxf(mx, shx(mx, 32, lane));
            const float mn = fmaxf(mrun, mx), alpha = __builtin_amdgcn_exp2f((mrun - mn) * l2e_);
            mrun = mn; lsum *= alpha;
#pragma unroll
            for (int dt = 0; dt < 8; ++dt) O[dt] = O[dt] * alpha;
        }
        const float mL = mrun * l2e_;
        unsigned pp[8];
#pragma unroll
        for (int nt = 0; nt < 4; ++nt) {
            float pv[4];
#pragma unroll
            for (int r = 0; r < 4; ++r) { pv[r] = __builtin_amdgcn_exp2f(Sx[nt][r] * l2e_ - mL); lsum += pv[r]; }
            pp[2 * nt] = pk2(pv[0], pv[1]); pp[2 * nt + 1] = pk2(pv[2], pv[3]);
        }
#pragma unroll
        for (int kk = 0; kk < 2; ++kk) {
            if (2 * kk + 1 >= nt_lo && 2 * kk <= nt_hi) {
                const u32x4 pb = {pp[4 * kk], pp[4 * kk + 1], pp[4 * kk + 2], pp[4 * kk + 3]};
                const bf16x8 Bf = __builtin_bit_cast(bf16x8, pb);
#pragma unroll
                for (int dt = 0; dt < 8; ++dt) {
                    const LAS unsigned char* vp = VS + (16 * dt + n16) * 144 + 2 * (32 * kk + 4 * g);
                    const s16x4 lo = *(const LAS s16x4*)vp, hi = *(const LAS s16x4*)(vp + 32);
                    O[dt] = MFMA16(cat4(lo, hi), Bf, O[dt]);
                }
            }
        }
    }
    lsum += shx(lsum, 16, lane); lsum += shx(lsum, 32, lane);
    __syncthreads();
    LAS float* MO = (LAS float*)L; LAS float* MM = (LAS float*)(L + 34048); LAS float* ML = MM + 64;
    const int q = 16 * qg + n16;
    if (kh == 1) {
#pragma unroll
        for (int dt = 0; dt < 8; ++dt) *(LAS f32x4*)(MO + q * 132 + 16 * dt + 4 * g) = O[dt];
        if (g == 0) { MM[q] = mrun; ML[q] = lsum; }
    }
    __syncthreads();
    if (kh == 0) {
        const float m1 = MM[q], l1 = ML[q], mn = fmaxf(mrun, m1), a0 = __builtin_amdgcn_exp2f((mrun - mn) * l2e_), a1 = __builtin_amdgcn_exp2f((m1 - mn) * l2e_);
        const float inv = 1.f / (lsum * a0 + l1 * a1);
        bf16_t* op = MIX + (size_t)(qrow0 + q) * D + 1536 + h * 128 + 4 * g;
#pragma unroll
        for (int dt = 0; dt < 8; ++dt) {
            const f32x4 o1 = *(const LAS f32x4*)(MO + q * 132 + 16 * dt + 4 * g);
            const f32x4 o = (O[dt] * a0 + o1 * a1) * inv;
            u32x2 w; w.x = pk2(o[0], o[1]); w.y = pk2(o[2], o[3]);
            *(u32x2*)(op + 16 * dt) = w;
        }
    }
    __syncthreads();
}

DI void mixer_phase(const Prm& p, LAS unsigned char* L, int l) {
    const int G = gridDim.x;
    unsigned* ctr = (unsigned*)(p.ws + WS_FLG) + l;
    LAS int* slot = (LAS int*)(L + LDS_BYTES - 16);
    int item = blockIdx.x;
    while (item < 1152) {
        int nxt_item = 0;
        if (threadIdx.x == 0) nxt_item = G + (int)__hip_atomic_fetch_add(ctr, 1u, __ATOMIC_RELAXED, __HIP_MEMORY_SCOPE_AGENT);
        if (item < 128) scan_item(p, L, l, 1, item >> 4, (item >> 1) & 7, item & 1);
        else if (item < 640) attn_item(p, L, l, 256 + (item - 128));
        else if (item < 896) { const int ix = item - 640; scan_item(p, L, l, 0, ix >> 4, (ix >> 1) & 7, ix & 1); }
        else attn_item(p, L, l, item - 896);
        if (threadIdx.x == 0) *slot = nxt_item;
        __syncthreads();
        item = *slot;
        __syncthreads();
    }
}

#ifndef PH_MASK
#define PH_MASK 0x3ff
#endif
#define PHASE_ON(bit) ((PH_MASK >> (bit)) & 1)
__global__ void __launch_bounds__(512, 2) mega_fwd(Prm p) {
    extern __shared__ __attribute__((aligned(16))) unsigned char lds_raw[];
    LAS unsigned char* L = (LAS unsigned char*)lds_raw;
    cg::grid_group grid = cg::this_grid();
    const int lo = p.ph_lo, hi = p.ph_hi;
    if (lo < 0) grid.sync();
    volatile LAS unsigned* xst = (volatile LAS unsigned*)(L + 131072);
    if (threadIdx.x < 2) xst[threadIdx.x] = 0u;
    __syncthreads();
    const XcdBarrier xb = xcd_barrier_post((unsigned*)(p.ws + WS_BAR), xst);
#define PH_BEGIN(n) if (lo <= (n) && (n) < hi) {
#define PH_END(n) if ((n) + 1 < hi) xcd_barrier(xb); }
    PH_BEGIN(0) if (PHASE_ON(0)) prologue_phase(p, L); PH_END(0)
#pragma nounroll
    for (int l = 0; l < 2; ++l) {
        const int pb = 1 + 8 * l;
        bf16_t* H = (bf16_t*)(p.ws + WS_H); bf16_t* MIX = (bf16_t*)(p.ws + WS_MIX); bf16_t* P = (bf16_t*)(p.ws + WS_P); float* X = (float*)(p.ws + WS_X);
        const float* MODl = (const float*)(p.ws + WS_MOD) + (size_t)l * 9 * 12288;
        PH_BEGIN(pb + 0) if (PHASE_ON(2)) norm_phase(p, l, 0, l == 0); PH_END(pb + 0)
        PH_BEGIN(pb + 1) if (PHASE_ON(3)) {
            pg8::StaticOrder S; pg8::Gemm g{H, (const bf16_t*)(p.ws + WS_WIN) + (size_t)l * NIN * D, T, NIN, D};
            EpiInProj E{P, (bf16_t*)(p.ws + WS_VT), (bf16_t*)(p.ws + WS_HIT), p.out + O_NK, p.out + O_NV, l};
            S.init(T, NIN, gridDim.x, blockIdx.x); pg8::gemm_phase<EpiInProj, pg8::StaticOrder>(L, g, S, E);
        } PH_END(pb + 1)
        PH_BEGIN(pb + 2) if (PHASE_ON(4)) mixer_phase(p, L, l); PH_END(pb + 2)
        PH_BEGIN(pb + 3) if (PHASE_ON(5)) combine_phase(p, l); PH_END(pb + 3)
        PH_BEGIN(pb + 4) if (PHASE_ON(6)) {
            pg8::HalfOrder<1> S; pg8::Gemm g{MIX, (const bf16_t*)(p.ws + WS_WOUT) + (size_t)l * D * D, T, D, D};
            EpiResid E{X, MODl + 4096, l == 0 ? p.in[0] : nullptr, l == 0 ? p.in[1] : nullptr};
            S.init(T, D, gridDim.x, blockIdx.x); pg8::gemm_phase<EpiResid, pg8::HalfOrder<1>>(L, g, S, E);
        } PH_END(pb + 4)
        PH_BEGIN(pb + 5) if (PHASE_ON(7)) norm_phase(p, l, 1, false); PH_END(pb + 5)
        PH_BEGIN(pb + 6) if (PHASE_ON(8)) {
            pg8::HalfOrder<2> S; pg8::Gemm g{H, (const bf16_t*)(p.ws + WS_WGU) + (size_t)l * NGU * D, T, NGU, D};
            EpiSwiGLU E{P};
            S.init(T, NGU, gridDim.x, blockIdx.x); pg8::gemm_phase<EpiSwiGLU, pg8::HalfOrder<2>>(L, g, S, E);
        } PH_END(pb + 6)
        PH_BEGIN(pb + 7) if (PHASE_ON(9)) {
            pg8::HalfOrder<1> S; pg8::Gemm g{P, (const bf16_t*)(p.ws + WS_WD) + (size_t)l * D * FF, T, D, FF};
            EpiResid E{X, MODl + 10240, nullptr, nullptr};
            S.init(T, D, gridDim.x, blockIdx.x); pg8::gemm_phase<EpiResid, pg8::HalfOrder<1>>(L, g, S, E);
        } PH_END(pb + 7)
    }
    PH_BEGIN(17) if (PHASE_ON(1)) norm_phase(p, 0, 2, false); PH_END(17)
}

extern "C" void kernel_launch(void* const* d_in, const int* in_sizes, int n_in, void* d_out, int out_size, void* d_ws, size_t ws_size, hipStream_t stream) {
    static int grid = 0;
    if (grid == 0) {
        if (n_in != 21 || ws_size < WS_END) { fprintf(stderr, "kernel_launch: need 21 inputs and %zu B of workspace; got %d, %zu\n", (size_t)WS_END, n_in, ws_size); grid = -1; return; }
        int dev = 0, cus = 0, per_cu = 0;
        hipGetDevice(&dev); hipDeviceGetAttribute(&cus, hipDeviceAttributeMultiprocessorCount, dev);
        if (hipFuncSetAttribute((const void*)mega_fwd, hipFuncAttributeMaxDynamicSharedMemorySize, LDS_BYTES) != hipSuccess) { fprintf(stderr, "kernel_launch: hipFuncSetAttribute failed\n"); grid = -1; return; }
        hipOccupancyMaxActiveBlocksPerMultiprocessor(&per_cu, (const void*)mega_fwd, 512, LDS_BYTES);
        (void)hipGetLastError();
        if (per_cu < 1) per_cu = 1;
        grid = cus * per_cu;
    }
    if (grid < 0) return;
    if (hipMemsetAsync((char*)d_ws + WS_FLG, 0, 4096 + 16384, stream) != hipSuccess) { fprintf(stderr, "kernel_launch: memset of control words failed\n"); return; }
    Prm p{};
    for (int i = 0; i < 21; ++i) p.in[i] = (const float*)d_in[i];
    p.out = (float*)d_out; p.ws = (unsigned char*)d_ws; p.ph_lo = 0; p.ph_hi = 18;
    void* args[] = {&p};
    hipError_t e = hipLaunchCooperativeKernel((const void*)mega_fwd, dim3(grid), dim3(512), args, LDS_BYTES, stream);
    if (e != hipSuccess) fprintf(stderr, "cooperative launch failed: %s (grid %d)\n", hipGetErrorString(e), grid);
}
```
